# Optimizing an MI355X kernel written in HIP

```python
import jax, jax.numpy as jnp
from jax import lax
import numpy as np

D_MODEL = 1024
BATCH = 8
SEQ = 4096
DEPTH = 1

D_MIX = D_MODEL
RWKV_WIDTH = D_MIX // 2
RWKV_HEAD = 64
RWKV_HEADS = RWKV_WIDTH // RWKV_HEAD
GMLP_WIDTH = D_MIX - RWKV_WIDTH
GMLP_GROUPS = 8
GMLP_GROUP_DIM = GMLP_WIDTH // GMLP_GROUPS
CHUNK = 128
DECAY_LORA = 64
AAA_LORA = 64
GATE_LORA = 128
D_FF = 2816
RMS_EPS = 1e-6
GN_EPS = 64e-5
LN_EPS = 1e-5
FFN_RES_SCALE = 0.5
D_SHIFT = 3 * RWKV_WIDTH + DECAY_LORA + AAA_LORA + GATE_LORA
D_IN = D_SHIFT + 2 * GMLP_WIDTH

kernel_name = "hymba_rwkv7_gmlp_macaron"


def rmsnorm(x, g):
    xf = x.astype(jnp.float32)
    y = xf * lax.rsqrt(jnp.mean(xf * xf, axis=-1, keepdims=True) + RMS_EPS)
    return (y * g.astype(jnp.float32)).astype(x.dtype)


def swiglu(h, w1, w3, w2):
    return (jax.nn.silu(h @ w1) * (h @ w3)) @ w2


def token_shift(p):
    return jnp.pad(p[:, :-1], ((0, 0), (1, 0), (0, 0)))


def rwkv7_scan(r, decay, k, v, a, b):
    seq_first = lambda t: jnp.transpose(t, (1, 0, 2, 3))
    B, _, H, N = r.shape

    def step(state, inp):
        r_t, w_t, k_t, v_t, a_t, b_t = inp
        sa = jnp.einsum('bhij,bhj->bhi', state, a_t)
        state = (state * w_t[:, :, None, :]
                 + sa[..., None] * b_t[:, :, None, :]
                 + v_t[..., None] * k_t[:, :, None, :])
        y_t = jnp.einsum('bhij,bhj->bhi', state, r_t)
        return state, y_t

    s0 = jnp.zeros((B, H, N, N), jnp.float32)
    _, ys = lax.scan(step, s0, tuple(seq_first(t) for t in (r, decay, k, v, a, b)))
    return jnp.transpose(ys, (1, 0, 2, 3))


def rwkv7_mixer(p, mu, w0, w_up, a0, a_up, g_up, k_k, k_a, r_k, gn_w, gn_b):
    B, S, _ = p.shape
    p = p + (token_shift(p) - p) * mu
    o1 = RWKV_WIDTH
    o2, o3 = 2 * o1, 3 * o1
    o4, o5 = o3 + DECAY_LORA, o3 + DECAY_LORA + AAA_LORA
    r, k, v = p[..., :o1], p[..., o1:o2], p[..., o2:o3]
    pw, pa, pg = p[..., o3:o4], p[..., o4:o5], p[..., o5:]
    w = -jax.nn.softplus(-(w0 + jnp.tanh(pw) @ w_up)) - 0.5
    decay = jnp.exp(-jnp.exp(w.astype(jnp.float32)))
    a = jax.nn.sigmoid(a0 + pa @ a_up)
    g = jax.nn.sigmoid(pg) @ g_up
    heads = lambda t: t.reshape(B, S, RWKV_HEADS, RWKV_HEAD).astype(jnp.float32)
    kk = heads(k * k_k)
    kk = kk / jnp.maximum(jnp.sqrt(jnp.sum(kk * kk, axis=-1, keepdims=True)), 1e-12)
    k = k * (1 + (a - 1) * k_a)
    rh, kh, vh, ah = heads(r), heads(k), heads(v), heads(a)
    y = rwkv7_scan(rh, heads(decay), kh, vh, -kk, kk * ah)
    mean = jnp.mean(y, axis=-1, keepdims=True)
    var = jnp.mean(jnp.square(y - mean), axis=-1, keepdims=True)
    y = (y - mean) * lax.rsqrt(var + GN_EPS)
    y = y * gn_w.reshape(RWKV_HEADS, RWKV_HEAD) + gn_b.reshape(RWKV_HEADS, RWKV_HEAD)
    bonus = jnp.sum(rh * kh * r_k.astype(jnp.float32), axis=-1, keepdims=True) * vh
    y = (y + bonus).reshape(B, S, RWKV_WIDTH).astype(p.dtype)
    return y * g


def gmlp_mixer(pu, pv, ln_g, ln_b, w_s, b_s):
    B, S, _ = pu.shape
    u = jax.nn.gelu(pu, approximate=False)
    vf = jax.nn.gelu(pv, approximate=False).astype(jnp.float32)
    mean = jnp.mean(vf, axis=-1, keepdims=True)
    var = jnp.mean(jnp.square(vf - mean), axis=-1, keepdims=True)
    vf = (vf - mean) * lax.rsqrt(var + LN_EPS) * ln_g + ln_b
    vc = vf.reshape(B, S // CHUNK, CHUNK, GMLP_GROUPS, GMLP_GROUP_DIM).astype(pu.dtype)
    w_causal = jnp.tril(w_s)
    mixed = jnp.einsum('gts,bcsgd->bctgd', w_causal, vc)
    mixed = mixed + jnp.transpose(b_s)[None, None, :, :, None]
    return u * mixed.reshape(B, S, GMLP_WIDTH)


def setup_inputs(seed: int = 0) -> dict:
    key = jax.random.key(seed)
    ks = jax.random.split(key, 32)
    f32 = jnp.float32
    nrm = lambda k, shape, s: jax.random.normal(k, shape, f32) * s
    L = DEPTH
    return {
        "x": jax.random.normal(ks[0], (BATCH, SEQ, D_MODEL), f32),
        "ffn1_norm": 1.0 + nrm(ks[1], (L, D_MODEL), 0.02),
        "ffn1_w1": nrm(ks[2], (L, D_MODEL, D_FF), D_MODEL ** -0.5),
        "ffn1_w3": nrm(ks[3], (L, D_MODEL, D_FF), D_MODEL ** -0.5),
        "ffn1_w2": nrm(ks[4], (L, D_FF, D_MODEL), D_FF ** -0.5),
        "mix_norm": 1.0 + nrm(ks[5], (L, D_MODEL), 0.02),
        "w_in": nrm(ks[6], (L, D_MODEL, D_IN), D_MODEL ** -0.5),
        "mu_shift": jax.random.uniform(ks[7], (L, D_SHIFT), f32),
        "w0": jax.random.uniform(ks[8], (L, RWKV_WIDTH), f32, -6.0, 0.0),
        "w_lora_up": nrm(ks[9], (L, DECAY_LORA, RWKV_WIDTH), 0.1 * DECAY_LORA ** -0.5),
        "a0": nrm(ks[10], (L, RWKV_WIDTH), 0.1),
        "a_lora_up": nrm(ks[11], (L, AAA_LORA, RWKV_WIDTH), 0.1 * AAA_LORA ** -0.5),
        "g_lora_up": nrm(ks[12], (L, GATE_LORA, RWKV_WIDTH), GATE_LORA ** -0.5),
        "k_k": 0.85 + nrm(ks[13], (L, RWKV_WIDTH), 0.02),
        "k_a": 1.0 + nrm(ks[14], (L, RWKV_WIDTH), 0.02),
        "r_k": nrm(ks[15], (L, RWKV_HEADS, RWKV_HEAD), 0.1),
        "gn_w": 1.0 + nrm(ks[16], (L, RWKV_WIDTH), 0.02),
        "gn_b": nrm(ks[17], (L, RWKV_WIDTH), 0.02),
        "sgu_ln_g": 1.0 + nrm(ks[18], (L, GMLP_WIDTH), 0.02),
        "sgu_ln_b": nrm(ks[19], (L, GMLP_WIDTH), 0.02),
        "sgu_w": nrm(ks[20], (L, GMLP_GROUPS, CHUNK, CHUNK), CHUNK ** -0.5),
        "sgu_b": 1.0 + nrm(ks[21], (L, GMLP_GROUPS, CHUNK), 0.02),
        "w_out": nrm(ks[22], (L, D_MIX, D_MODEL), D_MIX ** -0.5),
        "ffn2_norm": 1.0 + nrm(ks[23], (L, D_MODEL), 0.02),
        "ffn2_w1": nrm(ks[24], (L, D_MODEL, D_FF), D_MODEL ** -0.5),
        "ffn2_w3": nrm(ks[25], (L, D_MODEL, D_FF), D_MODEL ** -0.5),
        "ffn2_w2": nrm(ks[26], (L, D_FF, D_MODEL), D_FF ** -0.5),
        "final_norm": 1.0 + nrm(ks[27], (D_MODEL,), 0.02),
    }


def reference(x, ffn1_norm, ffn1_w1, ffn1_w3, ffn1_w2, mix_norm, w_in, mu_shift, w0, w_lora_up,
              a0, a_lora_up, g_lora_up, k_k, k_a, r_k, gn_w, gn_b, sgu_ln_g, sgu_ln_b, sgu_w,
              sgu_b, w_out, ffn2_norm, ffn2_w1, ffn2_w3, ffn2_w2, final_norm):
    for l in range(DEPTH):
        x = x + FFN_RES_SCALE * swiglu(rmsnorm(x, ffn1_norm[l]), ffn1_w1[l], ffn1_w3[l], ffn1_w2[l])
        h = rmsnorm(x, mix_norm[l])
        p = h @ w_in[l]
        y_rwkv = rwkv7_mixer(p[..., :D_SHIFT], mu_shift[l], w0[l], w_lora_up[l], a0[l],
                             a_lora_up[l], g_lora_up[l], k_k[l], k_a[l], r_k[l], gn_w[l], gn_b[l])
        y_gmlp = gmlp_mixer(p[..., D_SHIFT:D_SHIFT + GMLP_WIDTH], p[..., D_SHIFT + GMLP_WIDTH:],
                            sgu_ln_g[l], sgu_ln_b[l], sgu_w[l], sgu_b[l])
        x = x + jnp.concatenate([y_rwkv, y_gmlp], axis=-1) @ w_out[l]
        x = x + FFN_RES_SCALE * swiglu(rmsnorm(x, ffn2_norm[l]), ffn2_w1[l], ffn2_w3[l], ffn2_w2[l])
    return rmsnorm(x, final_norm)
```

```cpp
#include <hip/hip_runtime.h>
#include <hip/hip_cooperative_groups.h>
#include <cstdio>
#include <cstdint>
namespace cg = cooperative_groups;
namespace pg8 {
#define PG8_LAS __attribute__((address_space(3)))
typedef unsigned short bf16_t;
typedef short bf16x8 __attribute__((ext_vector_type(8)));
typedef float f32x4 __attribute__((ext_vector_type(4)));
typedef unsigned u32x4 __attribute__((ext_vector_type(4)));
constexpr int BM = 256, BK = 64, HALF = 128, HTB = HALF * BK * 2  , STAGE_BYTES = 8 * HTB, NXCD = 8, WGM = 4;

__host__ __device__ __forceinline__ int lds_byte(int r, int c) { const int st = (r >> 4) * 2 + (c >> 5), rr = r & 15, cc = c & 31, ob = rr * 64 + cc * 2; return st * 1024 + (ob ^ (((ob >> 9) & 1) << 5)); }
__host__ __device__ __forceinline__ void stage_rc(int b, int& R, int& C) { const int st = b / 1024, sb = b % 1024, swz = sb ^ (((sb >> 9) & 1) << 5); R = (st >> 1) * 16 + swz / 64; C = (st & 1) * 32 + (swz % 64) / 2; }
__host__ __device__ __forceinline__ int perm32(int rho) { const int n = rho >> 4, i = rho & 15; return 8 * (i >> 2) + 4 * n + (i & 3); }

struct Unit { int pm, pn; };
struct Gemm { const bf16_t* A; const bf16_t* Bt; int M, N, K; };

struct StaticOrder {
    int nM, nN, nwg, G, c;
    __host__ __device__ void init(int M, int N, int G_, int c_) { nM = M / BM; nN = N / BM; nwg = nM * nN; G = G_; c = c_; }
    __host__ __device__ bool next(int i, Unit& u) const {
        const long L = (long)i * G + c; if (L >= nwg) return false;
        int wgid = (int)L; { const int q = nwg / NXCD, r = nwg % NXCD, xcd = wgid % NXCD, off = wgid / NXCD; wgid = (xcd < r ? xcd * (q + 1) : r * (q + 1) + (xcd - r) * q) + off; }
        const int nig = WGM * nN, gid = wgid / nig, fm = gid * WGM, gsz = (nM - fm) < WGM ? (nM - fm) : WGM;
        u.pm = fm + ((wgid % nig) % gsz); u.pn = (wgid % nig) / gsz; return true;
    }
    __device__ __forceinline__ void a_ready(const Unit&) const {}
    __device__ __forceinline__ void done(const Unit&) const {}
};

typedef __bf16 bf16n2 __attribute__((ext_vector_type(2)));
typedef float f32n2 __attribute__((ext_vector_type(2)));
__device__ __forceinline__ unsigned cvt_pk_bf16(float lo, float hi) { const f32n2 f = {lo, hi}; return __builtin_bit_cast(unsigned, __builtin_convertvector(f, bf16n2)); }
typedef float f32x2 __attribute__((ext_vector_type(2)));
typedef unsigned u32n2 __attribute__((ext_vector_type(2)));
template <int CTRL> __device__ __forceinline__ float dpp_mov(float v) { return __builtin_bit_cast(float, __builtin_amdgcn_update_dpp(0, __builtin_bit_cast(int, v), CTRL, 0xf, 0xf, true)); }
__device__ __forceinline__ float sum_xor16(float v) { float w = v; asm volatile("" : "+v"(w)); const u32n2 r = __builtin_amdgcn_permlane16_swap(__builtin_bit_cast(unsigned, v), __builtin_bit_cast(unsigned, w), false, false);
    unsigned a = r.x, b = r.y; asm volatile("" : "+v"(a), "+v"(b)); return __builtin_bit_cast(float, a) + __builtin_bit_cast(float, b); }
__device__ __forceinline__ float sum_xor32(float v) { float w = v; asm volatile("" : "+v"(w)); const u32n2 r = __builtin_amdgcn_permlane32_swap(__builtin_bit_cast(unsigned, v), __builtin_bit_cast(unsigned, w), false, false);
    unsigned a = r.x, b = r.y; asm volatile("" : "+v"(a), "+v"(b)); return __builtin_bit_cast(float, a) + __builtin_bit_cast(float, b); }
__device__ __forceinline__ float sum_grp8(float v) { v += dpp_mov<0xB1>(v); v += dpp_mov<0x4E>(v); v += dpp_mov<0x141>(v); return v; }
__device__ __forceinline__ float sum_row16(float v) { v = sum_grp8(v); v += dpp_mov<0x140>(v); return v; }
__device__ __forceinline__ float sum_wave(float v) { return sum_xor32(sum_xor16(sum_row16(v))); }
__device__ __forceinline__ float fast_silu(float x) { return x * __builtin_amdgcn_rcpf(1.0f + __expf(-x)); }
template <int MODE> struct EpiScaled {
    static constexpr bool PERM = true, AFTER_DRAIN = false;
    bf16_t* O; int ldc; const float* ss; float eps;
    __device__ __forceinline__ void operator()(const f32x4 (&acc)[2][2][4][2], const Unit& u, int wr, int wc, int fr, int fq) const {
        const int row0 = u.pm * BM + wr * 64 + fr;
#pragma unroll
        for (int ai = 0; ai < 2; ++ai)
#pragma unroll
            for (int m = 0; m < 4; ++m) {
                const int row = row0 + ai * HALF + m * 16;
                const float rs = __builtin_amdgcn_rsqf(ss[row] * (1.0f / 1024.0f) + eps);
                if (MODE == 0) {
                    bf16_t* rowp = O + (size_t)row * ldc + u.pn * BM + wc * 32 + 8 * fq;
#pragma unroll
                    for (int bj = 0; bj < 2; ++bj) { const f32x4 v0 = acc[ai][bj][m][0] * rs, v1 = acc[ai][bj][m][1] * rs;
                        u32x4 w; w.x = cvt_pk_bf16(v0[0], v0[1]); w.y = cvt_pk_bf16(v0[2], v0[3]); w.z = cvt_pk_bf16(v1[0], v1[1]); w.w = cvt_pk_bf16(v1[2], v1[3]);
                        *(u32x4*)(rowp + bj * HALF) = w; }
                } else {
                    bf16_t* rowp = O + (size_t)row * ldc + u.pn * HALF + wc * 32 + 8 * fq;
                    float h[8];
#pragma unroll
                    for (int n = 0; n < 2; ++n)
#pragma unroll
                        for (int j = 0; j < 4; ++j) h[n * 4 + j] = fast_silu(acc[ai][0][m][n][j] * rs) * (acc[ai][1][m][n][j] * rs);
                    u32x4 w; w.x = cvt_pk_bf16(h[0], h[1]); w.y = cvt_pk_bf16(h[2], h[3]); w.z = cvt_pk_bf16(h[4], h[5]); w.w = cvt_pk_bf16(h[6], h[7]);
                    *(u32x4*)rowp = w;
                }
            }
    }
};
struct EpiResid {
    static constexpr bool PERM = true, AFTER_DRAIN = false;
    const float* base; const bf16_t* base16; float* out; bf16_t* xb; float* ss; float scale;
    __device__ __forceinline__ void operator()(const f32x4 (&acc)[2][2][4][2], const Unit& u, int wr, int wc, int fr, int fq) const {
        const int row0 = u.pm * BM + wr * 64 + fr, col0 = u.pn * BM + wc * 32 + 8 * fq;
#pragma unroll
        for (int ai = 0; ai < 2; ++ai) {
            f32x4 bv[4][2][2];
#pragma unroll
            for (int m = 0; m < 4; ++m)
#pragma unroll
                for (int bj = 0; bj < 2; ++bj) { const size_t off = (size_t)(row0 + ai * HALF + m * 16) * 1024 + col0 + bj * HALF;
                    if (base16) { const u32x4 w = *(const u32x4*)(base16 + off);
                        bv[m][bj][0] = (f32x4){__uint_as_float(w.x << 16), __uint_as_float(w.x & 0xffff0000u), __uint_as_float(w.y << 16), __uint_as_float(w.y & 0xffff0000u)};
                        bv[m][bj][1] = (f32x4){__uint_as_float(w.z << 16), __uint_as_float(w.z & 0xffff0000u), __uint_as_float(w.w << 16), __uint_as_float(w.w & 0xffff0000u)}; }
                    else { bv[m][bj][0] = *(const f32x4*)(base + off); bv[m][bj][1] = *(const f32x4*)(base + off + 4); } }
#pragma unroll
            for (int m = 0; m < 4; ++m) {
                const int row = row0 + ai * HALF + m * 16; float sq = 0.f;
#pragma unroll
                for (int bj = 0; bj < 2; ++bj) { const size_t off = (size_t)row * 1024 + col0 + bj * HALF;
                    const f32x4 o0 = bv[m][bj][0] + acc[ai][bj][m][0] * scale, o1 = bv[m][bj][1] + acc[ai][bj][m][1] * scale;
                    if (out) { *(f32x4*)(out + off) = o0; *(f32x4*)(out + off + 4) = o1; }
                    if (xb) { u32x4 w; w.x = cvt_pk_bf16(o0[0], o0[1]); w.y = cvt_pk_bf16(o0[2], o0[3]); w.z = cvt_pk_bf16(o1[0], o1[1]); w.w = cvt_pk_bf16(o1[2], o1[3]); *(u32x4*)(xb + off) = w; }
                    sq += (o0[0] * o0[0] + o0[1] * o0[1]) + (o0[2] * o0[2] + o0[3] * o0[3]) + (o1[0] * o1[0] + o1[1] * o1[1]) + (o1[2] * o1[2] + o1[3] * o1[3]); }
                sq = sum_xor32(sum_xor16(sq));
                if (fq == 0) atomicAdd(ss + row, sq);
            }
        }
    }
};
template <class Epi, class Sched, bool ALIGN_EPI = false, bool SP2 = false>
__device__ __forceinline__ void gemm_phase(PG8_LAS unsigned char* lds, const Gemm g, const Sched& S, const Epi& E, const int wid_in) {
    const int wid = wid_in, lane = (int)__builtin_amdgcn_mbcnt_hi(~0u, __builtin_amdgcn_mbcnt_lo(~0u, 0u)), tid = wid * 64 + lane, wr = wid >> 2, wc = wid & 3, fr = lane & 15, fq = lane >> 4;
    const int K = g.K, nt = K / BK;
    unsigned voffA[2], voffB[2];
#pragma unroll
    for (int i = 0; i < 2; ++i) { int R, C; stage_rc(tid * 16 + i * 8192, R, C); const int Rb = Epi::PERM ? ((R & ~31) + perm32(R & 31)) : R;
        voffA[i] = (unsigned)(R * K + C) * 2u; voffB[i] = (unsigned)(Rb * K + C) * 2u; }
    const size_t kstep = (size_t)(BK * 2);
    const size_t hstep = (size_t)HALF * K * 2;
    const size_t tstep = 2 * hstep;
    const unsigned ldsw = (unsigned)wid * 1024u;
    const int aoff = lds_byte(wr * 64 + fr, fq * 8), boff = lds_byte(wc * 32 + fr, fq * 8);
#define PG8_SA(b, h) (((b) * 2 + (h)) * HTB)
#define PG8_SB(b, h) ((4 + (b) * 2 + (h)) * HTB)
#define PG8_STAGE(bufoff, gbase, voff) do { _Pragma("unroll") for (int _i = 0; _i < 2; ++_i) \
        __builtin_amdgcn_global_load_lds((const unsigned*)((const char*)(gbase) + (voff)[_i]), (PG8_LAS unsigned*)(lds + (bufoff) + ldsw + _i * 8192), 16, 0, 0); } while (0)
#define PG8_LDA(dst, b, h) do { _Pragma("unroll") for (int m = 0; m < 4; ++m) _Pragma("unroll") for (int k = 0; k < 2; ++k) dst[m][k] = *(const PG8_LAS bf16x8*)(lds + PG8_SA(b, h) + aoff + m * 2048 + k * 1024); } while (0)
#define PG8_LDB(dst, b, h) do { _Pragma("unroll") for (int n = 0; n < 2; ++n) _Pragma("unroll") for (int k = 0; k < 2; ++k) dst[n][k] = *(const PG8_LAS bf16x8*)(lds + PG8_SB(b, h) + boff + n * 2048 + k * 1024); } while (0)
#define PG8_MMA(ai, bj, At, Bt) do { __builtin_amdgcn_s_setprio(1); _Pragma("unroll") for (int m = 0; m < 4; ++m) _Pragma("unroll") for (int n = 0; n < 2; ++n) _Pragma("unroll") for (int k = 0; k < 2; ++k) \
        acc[ai][bj][m][n] = __builtin_amdgcn_mfma_f32_16x16x32_bf16(Bt[n][k], At[m][k], acc[ai][bj][m][n], 0, 0, 0); __builtin_amdgcn_s_setprio(0); } while (0)
#define PG8_WAIT_V(n) asm volatile("s_waitcnt vmcnt(" #n ")" ::: "memory")
#define PG8_WAIT_L(n) asm volatile("s_waitcnt lgkmcnt(" #n ")" ::: "memory")
#define PG8_BAR __builtin_amdgcn_s_barrier()
#define PG8_SCHED __builtin_amdgcn_sched_barrier(0)
    Unit cur, nxt; int ui = 0;
    if (!S.next(0, cur)) return;
    f32x4 acc[2][2][4][2];
#pragma unroll
    for (int a = 0; a < 2; ++a)
#pragma unroll
        for (int b = 0; b < 2; ++b)
#pragma unroll
            for (int m = 0; m < 4; ++m)
#pragma unroll
                for (int n = 0; n < 2; ++n) acc[a][b][m][n] = (f32x4){0.f, 0.f, 0.f, 0.f};
    bf16x8 At[4][2], B0[2][2], B1[2][2];
    const char* cA = (const char*)g.A + (size_t)cur.pm * tstep; const char* cB = (const char*)g.Bt + (size_t)cur.pn * tstep;
    S.a_ready(cur);
    if constexpr (SP2) {
        PG8_STAGE(PG8_SB(0, 0), cB, voffB); PG8_STAGE(PG8_SB(0, 1), cB + hstep, voffB); PG8_STAGE(PG8_SA(0, 0), cA, voffA); PG8_STAGE(PG8_SA(0, 1), cA + hstep, voffA);
        if (wr == 1) PG8_BAR;
        PG8_WAIT_V(2); PG8_BAR;
        PG8_STAGE(PG8_SB(1, 0), cB + kstep, voffB); PG8_STAGE(PG8_SA(1, 0), cA + kstep, voffA); PG8_STAGE(PG8_SB(1, 1), cB + hstep + kstep, voffB);
        PG8_WAIT_V(6); PG8_BAR;
    } else {
        PG8_STAGE(PG8_SB(0, 0), cB, voffB); PG8_STAGE(PG8_SA(0, 0), cA, voffA); PG8_STAGE(PG8_SB(0, 1), cB + hstep, voffB); PG8_STAGE(PG8_SA(0, 1), cA + hstep, voffA);
        if (wr == 1) PG8_BAR;
        PG8_WAIT_V(4); PG8_BAR;
        PG8_STAGE(PG8_SB(1, 0), cB + kstep, voffB); PG8_STAGE(PG8_SA(1, 0), cA + kstep, voffA); PG8_STAGE(PG8_SB(1, 1), cB + hstep + kstep, voffB);
        PG8_WAIT_V(6); PG8_BAR;
    }
    for (;;) {
        const bool has_next = S.next(ui + 1, nxt);
        const char* nA = has_next ? (const char*)g.A + (size_t)nxt.pm * tstep : cA; const char* nB = has_next ? (const char*)g.Bt + (size_t)nxt.pn * tstep : cB;
        for (int t = 0; t < nt; t += 2) {
            const bool last = (t == nt - 2);
            const char* a1 = cA + (size_t)(t + 1) * kstep;
            const char* a2 = last ? nA : cA + (size_t)(t + 2) * kstep; const char* b2 = last ? nB : cB + (size_t)(t + 2) * kstep;
            const char* a3 = a2 + kstep; const char* b3 = b2 + kstep;
            if (last && has_next) S.a_ready(nxt);
            if constexpr (SP2) {
            PG8_LDB(B0, 0, 0); PG8_LDB(B1, 0, 1); PG8_SCHED; PG8_LDA(At, 0, 0); PG8_STAGE(PG8_SA(1, 1), a1 + hstep, voffA);
            PG8_WAIT_V(8); PG8_WAIT_L(0); PG8_BAR; PG8_MMA(0, 0, At, B0); PG8_MMA(0, 1, At, B1); PG8_BAR; PG8_SCHED;
            PG8_LDA(At, 0, 1); PG8_STAGE(PG8_SB(0, 0), b2, voffB); PG8_STAGE(PG8_SB(0, 1), b2 + hstep, voffB); PG8_STAGE(PG8_SA(0, 0), a2, voffA);
            PG8_WAIT_V(8); PG8_WAIT_L(0); PG8_BAR; PG8_MMA(1, 0, At, B0); PG8_MMA(1, 1, At, B1); PG8_BAR; PG8_SCHED;
            PG8_LDB(B0, 1, 0); PG8_LDB(B1, 1, 1); PG8_SCHED; PG8_LDA(At, 1, 0); PG8_STAGE(PG8_SA(0, 1), a2 + hstep, voffA);
            PG8_WAIT_V(8); PG8_WAIT_L(0); PG8_BAR; PG8_MMA(0, 0, At, B0); PG8_MMA(0, 1, At, B1); PG8_BAR; PG8_SCHED;
            PG8_LDA(At, 1, 1); PG8_STAGE(PG8_SB(1, 0), b3, voffB); PG8_STAGE(PG8_SB(1, 1), b3 + hstep, voffB); PG8_STAGE(PG8_SA(1, 0), a3, voffA);
            PG8_WAIT_V(8); PG8_WAIT_L(0); PG8_BAR; PG8_MMA(1, 0, At, B0); PG8_MMA(1, 1, At, B1); PG8_BAR; PG8_SCHED;
            } else {
            PG8_LDB(B0, 0, 0); PG8_SCHED; PG8_LDA(At, 0, 0); PG8_STAGE(PG8_SA(1, 1), a1 + hstep, voffA);
            PG8_WAIT_L(8); PG8_BAR; PG8_WAIT_L(0); PG8_MMA(0, 0, At, B0); PG8_BAR; PG8_SCHED;
            PG8_LDB(B1, 0, 1); PG8_STAGE(PG8_SB(0, 0), b2, voffB);
            PG8_BAR; PG8_WAIT_L(0); PG8_MMA(0, 1, At, B1); PG8_BAR;
            PG8_LDA(At, 0, 1); PG8_STAGE(PG8_SA(0, 0), a2, voffA);
            PG8_BAR; PG8_WAIT_L(0); PG8_MMA(1, 0, At, B0); PG8_BAR; PG8_SCHED;
            PG8_STAGE(PG8_SB(0, 1), b2 + hstep, voffB);
            PG8_WAIT_V(6); PG8_BAR; PG8_MMA(1, 1, At, B1); PG8_BAR;
            PG8_LDB(B0, 1, 0); PG8_SCHED; PG8_LDA(At, 1, 0); PG8_STAGE(PG8_SA(0, 1), a2 + hstep, voffA);
            PG8_WAIT_L(8); PG8_BAR; PG8_WAIT_L(0); PG8_MMA(0, 0, At, B0); PG8_BAR; PG8_SCHED;
            PG8_LDB(B1, 1, 1); PG8_STAGE(PG8_SB(1, 0), b3, voffB);
            PG8_BAR; PG8_WAIT_L(0); PG8_MMA(0, 1, At, B1); PG8_BAR;
            PG8_LDA(At, 1, 1); PG8_STAGE(PG8_SA(1, 0), a3, voffA);
            PG8_BAR; PG8_WAIT_L(0); PG8_MMA(1, 0, At, B0); PG8_BAR; PG8_SCHED;
            PG8_STAGE(PG8_SB(1, 1), b3 + hstep, voffB);
            PG8_WAIT_V(6); PG8_BAR; PG8_MMA(1, 1, At, B1); PG8_BAR;
            }
        }
        if constexpr (ALIGN_EPI) { if (wr == 0) PG8_BAR; }
        if constexpr (!Epi::AFTER_DRAIN) { E(acc, cur, wr, wc, fr, fq); S.done(cur); }
        if (!has_next) break;
#pragma unroll
        for (int a = 0; a < 2; ++a)
#pragma unroll
            for (int b = 0; b < 2; ++b)
#pragma unroll
                for (int m = 0; m < 4; ++m)
#pragma unroll
                    for (int n = 0; n < 2; ++n) acc[a][b][m][n] = (f32x4){0.f, 0.f, 0.f, 0.f};
        cur = nxt; cA = nA; cB = nB; ++ui;
        if constexpr (ALIGN_EPI) { if (wr == 1) PG8_BAR; }
    }
    PG8_WAIT_V(0);
    if constexpr (!ALIGN_EPI) { if (wr == 0) PG8_BAR; }
    PG8_BAR;
    if constexpr (Epi::AFTER_DRAIN) { E.fused(acc, cur, wr, wc, fr, fq, lds, wid, lane); S.done(cur); }
#undef PG8_SA
#undef PG8_SB
#undef PG8_STAGE
#undef PG8_LDA
#undef PG8_LDB
#undef PG8_MMA
#undef PG8_WAIT_V
#undef PG8_WAIT_L
#undef PG8_BAR
#undef PG8_SCHED
}
}

#ifndef MK_SPLIT
#define MK_SPLIT 0
#endif
#define LAS __attribute__((address_space(3)))
typedef unsigned short bf16;
typedef unsigned v4u __attribute__((ext_vector_type(4)));
typedef unsigned v2u __attribute__((ext_vector_type(2)));
typedef float f32x4 __attribute__((ext_vector_type(4)));
typedef short bf16x8 __attribute__((ext_vector_type(8)));

constexpr int NWAVES = 8, NTHREADS = 512;
constexpr int M = 32768, SEQ = 4096, D = 1024, FF = 2816, NUP = 5632, DIN = 2816, RW = 512, NPHASE = 12;
constexpr float RMS_EPS = 1e-6f, GN_EPS = 64e-5f, LN_EPS = 1e-5f;
constexpr size_t MiB = 1u << 20;
constexpr size_t WS_W13_1 = 0, WS_W2_1 = 11 * MiB, WS_W13_2 = 17 * MiB, WS_W2_2 = 28 * MiB, WS_WIN = 34 * MiB, WS_WOUT = 40 * MiB,
    WS_WUPT = 42 * MiB, WS_AUPT = 42 * MiB + 65536, WS_GUPT = 42 * MiB + 131072, WS_WC = 42 * MiB + 262144, WS_SS = 43 * MiB, WS_BAR = 43 * MiB + 786432  ,
    WS_P = 44 * MiB  , WS_RK = 220 * MiB, WS_AB = 284 * MiB, WS_WD = 348 * MiB  , WS_V = 412 * MiB,
    WS_YCAT = 444 * MiB, WS_GAM = 508 * MiB  , WS_END = 512 * MiB;
constexpr int OPS_BYTES = 11264, OP_A = 0, OP_R = 2048, OP_BK = 4096, OP_N = 8192, OP_M = 8704, OP_V = 9216;
constexpr int LDS_BYTES = 153856;

#define LDS_WAIT() asm volatile("s_waitcnt lgkmcnt(0)" ::: "memory")
__device__ __forceinline__ float bf_lo(unsigned u) { return __uint_as_float(u << 16); }
__device__ __forceinline__ float bf_hi(unsigned u) { return __uint_as_float(u & 0xffff0000u); }
__device__ __forceinline__ unsigned pk(float lo, float hi) { return pg8::cvt_pk_bf16(lo, hi); }
__device__ __forceinline__ float wave_sum(float v) { return pg8::sum_wave(v); }
__device__ __forceinline__ float gelu_erf(float x) { return 0.5f * x * (1.0f + erff(x * 0.70710678118654752f)); }
__device__ __forceinline__ float sigmoidf(float x) { return __builtin_amdgcn_rcpf(1.0f + __expf(-x)); }

struct TItem { const float* W; bf16* WT; const float* gk; int K, N, mode, item; };
__device__ __forceinline__ void titem_load(const TItem& ti, float (&v)[32], int lane) {
    const int nblk = ti.N / 32, kb = ti.item / nblk, nb = ti.item % nblk;
    const float* src = ti.W + (size_t)(64 * kb + (lane >> 5)) * ti.N + 32 * nb + (lane & 31);
#pragma unroll
    for (int i = 0; i < 32; ++i) v[i] = src[(size_t)(2 * i) * ti.N];
}
__device__ __forceinline__ void titem_store(const TItem& ti, const float (&v)[32], LAS float* scr, int lane) {
    const int nblk = ti.N / 32, kb = ti.item / nblk, nb = ti.item % nblk, k0 = 64 * kb, n0 = 32 * nb;
#pragma unroll
    for (int i = 0; i < 32; ++i) scr[(2 * i + (lane >> 5)) * 33 + (lane & 31)] = v[i];
    LDS_WAIT(); asm volatile("" ::: "memory");
    const int c = lane & 7;
    f32x4 g0 = (f32x4){1.f, 1.f, 1.f, 1.f}, g1 = g0;
    if (ti.gk) { g0 = *(const f32x4*)(ti.gk + k0 + 8 * c); g1 = *(const f32x4*)(ti.gk + k0 + 8 * c + 4); }
    const int d0 = (ti.mode == 0) ? n0 : ((n0 >> 7) * 256 + (n0 & 127) + (ti.mode == 2 ? 128 : 0));
#pragma unroll
    for (int j = 0; j < 4; ++j) { const int n = (lane >> 3) + 8 * j; const LAS float* sp = scr + (8 * c) * 33 + n;
        v4u o; o.x = pk(sp[0 * 33] * g0.x, sp[1 * 33] * g0.y); o.y = pk(sp[2 * 33] * g0.z, sp[3 * 33] * g0.w); o.z = pk(sp[4 * 33] * g1.x, sp[5 * 33] * g1.y); o.w = pk(sp[6 * 33] * g1.z, sp[7 * 33] * g1.w);
        *(v4u*)(ti.WT + (size_t)(d0 + n) * ti.K + k0 + 8 * c) = o; }
    LDS_WAIT(); asm volatile("" ::: "memory");
}

#define XB_TMO      128
#define XB_XCNT(j)  (256  + 64 * (j))
#define XB_XSUB(j)  (1280 + 64 * (j))
#define XB_XGEN(j)  (2304 + 64 * (j))
#define XB_TOP      3328
#define XB_TOPGEN   3392
#define XCD_BAR_WORDS 3456
#define XB_SPIN_CAP (1u << 18)

__device__ __forceinline__ unsigned xb_ld(unsigned* p)              { return __hip_atomic_load(p, __ATOMIC_RELAXED, __HIP_MEMORY_SCOPE_AGENT); }
__device__ __forceinline__ unsigned xb_add(unsigned* p, unsigned v) { return __hip_atomic_fetch_add(p, v, __ATOMIC_RELAXED, __HIP_MEMORY_SCOPE_AGENT); }
__device__ __forceinline__ unsigned xb_xcc_id() { return (unsigned)__builtin_amdgcn_s_getreg((3 << 11) | 20) & 0xFu; }
#define XB_SPIN(cond, bar) do { unsigned _sp = 0; while (cond) { __builtin_amdgcn_s_sleep(1); \
    if ((++_sp & 255u) == 0u) { if (xb_ld(&(bar)[XB_TMO])) break; if (_sp > XB_SPIN_CAP) { atomicAdd(&(bar)[XB_TMO], 1u); break; } } } } while (0)

struct XcdBarrier {
    unsigned* bar; unsigned x;
    volatile LAS unsigned* st;
};

__device__ __forceinline__ XcdBarrier xcd_barrier_post(unsigned* bar, volatile LAS unsigned* st) {
    XcdBarrier b; b.bar = bar; b.x = xb_xcc_id(); b.st = st;
    if (threadIdx.x == 0) (void)xb_add(&bar[XB_XCNT(b.x)], 1u);
    return b;
}
__device__ __forceinline__ void xcd_barrier_complete(unsigned* bar, unsigned x, unsigned& nloc, unsigned& nx) {
    const unsigned G = gridDim.x * gridDim.y * gridDim.z;
    unsigned sum, cnt, mine, sp = 0u;
    for (;;) {
        sum = 0u; cnt = 0u; mine = 0u;
#pragma unroll
        for (unsigned j = 0; j < 16; ++j) { const unsigned c = xb_ld(&bar[XB_XCNT(j)]); sum += c; cnt += (c > 0u) ? 1u : 0u; mine = (j == x) ? c : mine; }
        if (sum == G) break;
        __builtin_amdgcn_s_sleep(1);
        if ((++sp & 255u) == 0u) { if (xb_ld(&bar[XB_TMO])) break; if (sp > XB_SPIN_CAP) { atomicAdd(&bar[XB_TMO], 1u); break; } }
    }
    nloc = mine > 0u ? mine : 1u; nx = cnt > 0u ? cnt : 1u;
}

__device__ __forceinline__ void xcd_barrier(const XcdBarrier& b) {
    asm volatile("s_waitcnt vmcnt(0)" ::: "memory");
    __syncthreads();
    if (threadIdx.x == 0) {
        unsigned* bar = b.bar;
        __builtin_amdgcn_s_waitcnt(0);
        unsigned nloc = b.st[0], nx = b.st[1];
        if (nloc == 0u) { xcd_barrier_complete(bar, b.x, nloc, nx); b.st[0] = nloc; b.st[1] = nx; }
        const unsigned old = xb_add(&bar[XB_XSUB(b.x)], 1u);
        const unsigned gen = old / nloc;
        if (old + 1u == (gen + 1u) * nloc) {
            __builtin_amdgcn_fence(__ATOMIC_RELEASE, "agent");
            asm volatile("s_waitcnt vmcnt(0)" ::: "memory");
            const unsigned og = xb_add(&bar[XB_TOP], 1u);
            const unsigned tg = og / nx;
            if (og + 1u == (tg + 1u) * nx) xb_add(&bar[XB_TOPGEN], 1u);
            else XB_SPIN(xb_ld(&bar[XB_TOPGEN]) == tg, bar);
            __builtin_amdgcn_fence(__ATOMIC_ACQUIRE, "agent");
            xb_add(&bar[XB_XGEN(b.x)], 1u);
            asm volatile("s_waitcnt vmcnt(0)" ::: "memory");
        } else {
            XB_SPIN(xb_ld(&bar[XB_XGEN(b.x)]) == gen, bar);
            __builtin_amdgcn_fence(__ATOMIC_ACQUIRE, "agent");
            asm volatile("s_waitcnt vmcnt(0)" ::: "memory");
        }
    }
    __syncthreads();
}

struct Args { const float* in[28]; float* out; unsigned char* ws; int ph_lo, ph_hi; };

__device__ __forceinline__ void p0_prologue(const Args& a, LAS unsigned char* lds, int wave, int lane) {
    unsigned char* ws = a.ws;
    LAS float* scr = (LAS float*)(lds + wave * 16384);
    const int gw = blockIdx.x * NWAVES + wave, NGW = gridDim.x * NWAVES;
    constexpr int I_UP = (D / 64) * (FF / 32), I_DN = (FF / 64) * (D / 32), I_IN = (D / 64) * (DIN / 32), I_OUT = (D / 64) * (D / 32), I_L64 = RW / 32, I_L128 = 2 * (RW / 32);
    constexpr int NITEMS = 4 * I_UP + 2 * I_DN + I_IN + I_OUT + 2 * I_L64 + I_L128;
#define P0_DECODE(it_, ti) do { int r = (it_); \
        if (r < I_UP) { ti = TItem{a.in[2], (bf16*)(ws + WS_W13_1), a.in[1], D, FF, 1, r}; break; } r -= I_UP; \
        if (r < I_UP) { ti = TItem{a.in[3], (bf16*)(ws + WS_W13_1), a.in[1], D, FF, 2, r}; break; } r -= I_UP; \
        if (r < I_DN) { ti = TItem{a.in[4], (bf16*)(ws + WS_W2_1), nullptr, FF, D, 0, r}; break; } r -= I_DN; \
        if (r < I_UP) { ti = TItem{a.in[24], (bf16*)(ws + WS_W13_2), a.in[23], D, FF, 1, r}; break; } r -= I_UP; \
        if (r < I_UP) { ti = TItem{a.in[25], (bf16*)(ws + WS_W13_2), a.in[23], D, FF, 2, r}; break; } r -= I_UP; \
        if (r < I_DN) { ti = TItem{a.in[26], (bf16*)(ws + WS_W2_2), nullptr, FF, D, 0, r}; break; } r -= I_DN; \
        if (r < I_IN) { ti = TItem{a.in[6], (bf16*)(ws + WS_WIN), a.in[5], D, DIN, 0, r}; break; } r -= I_IN; \
        if (r < I_OUT) { ti = TItem{a.in[22], (bf16*)(ws + WS_WOUT), nullptr, D, D, 0, r}; break; } r -= I_OUT; \
        if (r < I_L64) { ti = TItem{a.in[9], (bf16*)(ws + WS_WUPT), nullptr, 64, RW, 0, r}; break; } r -= I_L64; \
        if (r < I_L64) { ti = TItem{a.in[11], (bf16*)(ws + WS_AUPT), nullptr, 64, RW, 0, r}; break; } r -= I_L64; \
        ti = TItem{a.in[12], (bf16*)(ws + WS_GUPT), nullptr, 128, RW, 0, r}; } while (0)
    if (gw < NITEMS) { TItem cur; float v[32]; P0_DECODE(gw, cur); titem_load(cur, v, lane);
        for (int it = gw; it < NITEMS; it += NGW) {
            const bool has = it + NGW < NITEMS; TItem nx = cur; float v2[32];
            if (has) { P0_DECODE(it + NGW, nx); titem_load(nx, v2, lane); }
            titem_store(cur, v, scr, lane);
            if (has) { cur = nx;
#pragma unroll
                for (int i = 0; i < 32; ++i) v[i] = v2[i]; }
        } }
#undef P0_DECODE
    { const float* sw = a.in[20]; bf16* wc = (bf16*)(ws + WS_WC);
      for (int i = blockIdx.x * NTHREADS + wave * 64 + lane; i < 8 * 128 * 128 / 2; i += gridDim.x * NTHREADS) {
          const int e = 2 * i, s = e & 127, t = (e >> 7) & 127;
          const float v0 = (s <= t) ? sw[e] : 0.f, v1 = (s + 1 <= t) ? sw[e + 1] : 0.f;
          ((unsigned*)wc)[i] = pk(v0, v1); } }
    { const float* x = a.in[0]; bf16* xb = (bf16*)(ws + WS_WD); float* ss = (float*)(ws + WS_SS);
      f32x4 v[4];
#define X_LOAD(mm) do { const f32x4* xr_ = (const f32x4*)(x + (size_t)(mm) * D) + lane; _Pragma("unroll") for (int j = 0; j < 4; ++j) v[j] = __builtin_nontemporal_load(xr_ + 64 * j); } while (0)
      if (gw < M) X_LOAD(gw);
      for (int m = gw; m < M; m += NGW) {
          v2u* o8 = (v2u*)(xb + (size_t)m * D) + lane; float s = 0.f; v2u o[4];
#pragma unroll
          for (int j = 0; j < 4; ++j) { s += (v[j].x * v[j].x + v[j].y * v[j].y) + (v[j].z * v[j].z + v[j].w * v[j].w); o[j].x = pk(v[j].x, v[j].y); o[j].y = pk(v[j].z, v[j].w); }
          { const int mn = m + NGW < M ? m + NGW : m; X_LOAD(mn); }
#pragma unroll
          for (int j = 0; j < 4; ++j) o8[64 * j] = o[j];
          s = wave_sum(s);
          if (lane == 0) { ss[m] = s; ss[M + m] = 0.f; ss[2 * M + m] = 0.f; ss[3 * M + m] = 0.f; }
      }
#undef X_LOAD
      }
}

__device__ __forceinline__ f32x4 ld_bf4(const bf16* p) { const v2u u = *(const v2u*)p; return (f32x4){bf_lo(u.x), bf_hi(u.x), bf_lo(u.y), bf_hi(u.y)}; }
__device__ __forceinline__ f32x4 un_bf4(v2u u) { return (f32x4){bf_lo(u.x), bf_hi(u.x), bf_lo(u.y), bf_hi(u.y)}; }
__device__ __forceinline__ float gelu_as(float v) {
    const float t = __builtin_amdgcn_rcpf(fabsf(v) * 0.2316418882f + 1.0f);
    float q = t * 0.5307027145f + (-0.7265760135f); q = q * t + 0.7107068705f; q = q * t + (-0.142248368f); q = q * t + 0.127414796f; q = q * t;
    const float m = v * (q * __builtin_amdgcn_exp2f(v * v * (-0.72134752044f)));
    return v < 0.f ? m : v - m;
}
struct PV { v2u rc, rp, kc, kp; f32x4 rk; };
__device__ __forceinline__ void mp_load_pv(PV (&pv)[4], const bf16* P, const float* rkp, int t0, bool seq_start, int tb, int h, int fr, int fq) {
    const int tr = 16 * tb + fr; const bf16* pc = P + (size_t)(t0 + tr) * DIN + 64 * h + 4 * fq; const bf16* pp = (tr == 0 && seq_start) ? pc : pc - DIN;
#pragma unroll
    for (int nb = 0; nb < 4; ++nb) { pv[nb].rc = *(const v2u*)(pc + 16 * nb); pv[nb].kc = *(const v2u*)(pc + 512 + 16 * nb);
        pv[nb].rp = *(const v2u*)(pp + 16 * nb); pv[nb].kp = *(const v2u*)(pp + 512 + 16 * nb); pv[nb].rk = *(const f32x4*)(rkp + 64 * h + 16 * nb + 4 * fq); }
}
__device__ __forceinline__ void mp_a1_pre(const PV (&pv)[4], const LAS float* par, int t0, bool seq_start, int tb, int h, int fr, int fq, bf16* R, v2u (&kraw)[4], v2u (&rvp)[4], f32x4 (&rkv)[4], float& inv) {
    const int tr = 16 * tb + fr; const size_t t = (size_t)(t0 + tr); const float keep = (tr == 0 && seq_start) ? 0.f : 1.f;
    float ssq = 0.f;
#pragma unroll
    for (int nb = 0; nb < 4; ++nb) { const int cl = 16 * nb + 4 * fq;
        const f32x4 kc = un_bf4(pv[nb].kc), kp = un_bf4(pv[nb].kp) * keep, rc = un_bf4(pv[nb].rc), rp = un_bf4(pv[nb].rp) * keep;
        const f32x4 kv = kc + (kp - kc) * *(const LAS f32x4*)(par + 64 + cl); kraw[nb].x = pk(kv.x, kv.y); kraw[nb].y = pk(kv.z, kv.w);
        const f32x4 kk = kv * *(const LAS f32x4*)(par + 320 + cl); ssq += (kk.x * kk.x + kk.y * kk.y) + (kk.z * kk.z + kk.w * kk.w);
        const f32x4 rv = rc + (rp - rc) * *(const LAS f32x4*)(par + cl);
        v2u r2; r2.x = pk(rv.x, rv.y); r2.y = pk(rv.z, rv.w); *(v2u*)(R + t * RW + 64 * h + cl) = r2; rvp[nb] = r2; rkv[nb] = pv[nb].rk; }
    ssq = pg8::sum_xor32(pg8::sum_xor16(ssq));
    inv = 1.0f / fmaxf(sqrtf(ssq), 1e-12f);
}
struct A1Pend { v4u ab; f32x4 dec; v2u k2, g; size_t o, og; };
__device__ __forceinline__ void mp_a1_flush(const A1Pend& pe, bf16* K2, unsigned* AB, float* WD, bf16* YC) {
    *(v2u*)(K2 + pe.o) = pe.k2; *(v4u*)(AB + pe.o) = pe.ab; *(f32x4*)(WD + pe.o) = pe.dec; *(v2u*)(YC + pe.og) = pe.g;
}
__device__ __forceinline__ void mp_a1_main(const v2u (&kraw)[4], const v2u (&rvp)[4], const f32x4 (&rkv)[4], float* BON, float inv, const LAS bf16* Alow, const LAS float* par, const LAS bf16* wl, int t0, int tb, int h, int fr, int fq,
                                           bf16* K2, unsigned* AB, bf16* WD, bf16* YC) {
    constexpr int AL = 264;
    const LAS bf16* xrow = Alow + (16 * tb + fr) * AL + fq * 8;
    const size_t t = (size_t)(t0 + 16 * tb + fr);
    v2u sk[4], sg[4], sdec[4]; v4u sab[4]; float bon = 0.f;
#pragma unroll
    for (int nb = 0; nb < 4; ++nb) {
        const int nrow = 16 * nb + fr;
        bf16x8 fw[2], fa[2], fg[4];
#pragma unroll
        for (int ks = 0; ks < 2; ++ks) { fw[ks] = *(const LAS bf16x8*)(wl + nrow * 72 + ks * 32 + fq * 8); fa[ks] = *(const LAS bf16x8*)(wl + 4608 + nrow * 72 + ks * 32 + fq * 8); }
#pragma unroll
        for (int ks = 0; ks < 4; ++ks) fg[ks] = *(const LAS bf16x8*)(wl + 9216 + nrow * 136 + ks * 32 + fq * 8);
        f32x4 cw = (f32x4){0.f, 0.f, 0.f, 0.f}, ca = cw, cgv = cw;
#pragma unroll
        for (int ks = 0; ks < 2; ++ks) {
            cw = __builtin_amdgcn_mfma_f32_16x16x32_bf16(fw[ks], *(const LAS bf16x8*)(xrow + ks * 32), cw, 0, 0, 0);
            ca = __builtin_amdgcn_mfma_f32_16x16x32_bf16(fa[ks], *(const LAS bf16x8*)(xrow + 64 + ks * 32), ca, 0, 0, 0); }
#pragma unroll
        for (int ks = 0; ks < 4; ++ks)
            cgv = __builtin_amdgcn_mfma_f32_16x16x32_bf16(fg[ks], *(const LAS bf16x8*)(xrow + 128 + ks * 32), cgv, 0, 0, 0);
        const int cl = 16 * nb + 4 * fq, c = 64 * h + cl;
        const f32x4 wl = cw + *(const LAS f32x4*)(par + 192 + cl), al = ca + *(const LAS f32x4*)(par + 256 + cl);
        const f32x4 kkc = *(const LAS f32x4*)(par + 320 + cl), kac = *(const LAS f32x4*)(par + 384 + cl);
        const f32x4 kr = un_bf4(kraw[nb]), rq = un_bf4(rvp[nb]); f32x4 kn4, dec; v4u ab4;
#pragma unroll
        for (int j = 0; j < 4; ++j) {
            dec[j] = -0.60653065971263342f * sigmoidf(wl[j]);
            const float alpha = sigmoidf(al[j]);
            const float kkn = kr[j] * kkc[j] * inv;
            kn4[j] = kr[j] * (1.0f + (alpha - 1.0f) * kac[j]);
            bon = fmaf(rq[j] * kn4[j], rkv[nb][j], bon);
            ab4[j] = pk(-kkn, kkn * alpha); }
        sk[nb].x = pk(kn4.x, kn4.y); sk[nb].y = pk(kn4.z, kn4.w); sab[nb] = ab4; sdec[nb].x = pk(dec.x, dec.y); sdec[nb].y = pk(dec.z, dec.w); sg[nb].x = pk(cgv.x, cgv.y); sg[nb].y = pk(cgv.z, cgv.w); }
    const size_t o0 = t * RW + 64 * h + 4 * fq;
#pragma unroll
    for (int nb = 0; nb < 4; ++nb) *(v2u*)(K2 + o0 + 16 * nb) = sk[nb];
#pragma unroll
    for (int nb = 0; nb < 4; ++nb) *(v4u*)(AB + o0 + 16 * nb) = sab[nb];
#pragma unroll
    for (int nb = 0; nb < 4; ++nb) *(v2u*)(WD + o0 + 16 * nb) = sdec[nb];
#pragma unroll
    for (int nb = 0; nb < 4; ++nb) *(v2u*)(YC + t * D + 64 * h + 4 * fq + 16 * nb) = sg[nb];
    bon = pg8::sum_xor32(pg8::sum_xor16(bon)); if (fq == 0) BON[t * 8 + h] = bon;
}
struct B1L { bf16x8 bfr[4]; v2u pu[4]; float bias; };
__device__ __forceinline__ void mp_load_b1(B1L& L, const bf16* P, const bf16* Wc, const float* sb, int t0, int tb, int g, int fr, int fq) {
    const int nks = (tb >> 1) + 1, tr = 16 * tb + fr;
#pragma unroll
    for (int ks = 0; ks < 4; ++ks) if (ks < nks) L.bfr[ks] = *(const bf16x8*)(Wc + (size_t)(g * 128 + tr) * 128 + ks * 32 + fq * 8);
#pragma unroll
    for (int cb = 0; cb < 4; ++cb) L.pu[cb] = *(const v2u*)(P + (size_t)(t0 + tr) * DIN + 1792 + 64 * g + 16 * cb + 4 * fq);
    L.bias = sb[g * 128 + tr];
}
__device__ __forceinline__ void mp_b1_body(const B1L& L, const LAS bf16* Vt, bf16* YC, int t0, int tb, int g, int fr, int fq) {
    constexpr int VP = 136; const int nks = (tb >> 1) + 1; const size_t t = (size_t)(t0 + 16 * tb + fr);
#pragma unroll
    for (int cb = 0; cb < 4; ++cb) { f32x4 acc = (f32x4){0.f, 0.f, 0.f, 0.f};
#pragma unroll
        for (int ks = 0; ks < 4; ++ks) if (ks < nks)
            acc = __builtin_amdgcn_mfma_f32_16x16x32_bf16(*(const LAS bf16x8*)(Vt + ((fr & 7) * 65 + 8 * g + 2 * cb + (fr >> 3)) * VP + ks * 32 + fq * 8), L.bfr[ks], acc, 0, 0, 0);
        const int c = 64 * g + 16 * cb + 4 * fq; const f32x4 pu = un_bf4(L.pu[cb]);
        v2u o; o.x = pk(gelu_as(pu.x) * (acc.x + L.bias), gelu_as(pu.y) * (acc.y + L.bias)); o.y = pk(gelu_as(pu.z) * (acc.z + L.bias), gelu_as(pu.w) * (acc.w + L.bias));
        *(v2u*)(YC + t * D + 512 + c) = o; }
}
__device__ __forceinline__ void mp_stage_load(v4u (&wst)[4], const bf16* wupT, const bf16* aupT, const bf16* gupT, int h, int tid) {
    const unsigned off = (unsigned)tid * 16u;
    wst[0] = *(const v4u*)((const char*)(wupT + (size_t)h * 4096) + off);
    wst[1] = *(const v4u*)((const char*)(aupT + (size_t)h * 4096) + off);
    wst[2] = *(const v4u*)((const char*)(gupT + (size_t)h * 8192) + off);
    wst[3] = *(const v4u*)((const char*)(gupT + (size_t)h * 8192) + 8192 + off);
}
__device__ __forceinline__ void mp_stage_store(const v4u (&wst)[4], LAS bf16* wl, int tid) {
    *(LAS v4u*)(wl + (tid >> 3) * 72 + (tid & 7) * 8) = wst[0];
    *(LAS v4u*)(wl + 4608 + (tid >> 3) * 72 + (tid & 7) * 8) = wst[1];
    *(LAS v4u*)(wl + 9216 + (tid >> 4) * 136 + (tid & 15) * 8) = wst[2];
    *(LAS v4u*)(wl + 9216 + (32 + (tid >> 4)) * 136 + (tid & 15) * 8) = wst[3];
}
__device__ __forceinline__ void mixer_prep(const Args& a, LAS unsigned char* lds, int wave, int lane) {
    unsigned char* ws = a.ws;
    const bf16* P = (const bf16*)(ws + WS_P);
    const float* mu = a.in[7];
    const bf16* wupT = (const bf16*)(ws + WS_WUPT); const bf16* aupT = (const bf16*)(ws + WS_AUPT); const bf16* gupT = (const bf16*)(ws + WS_GUPT); const bf16* Wc = (const bf16*)(ws + WS_WC);
    bf16* RB = (bf16*)(ws + WS_RK); bf16* K2 = (bf16*)(ws + WS_RK + 32 * MiB); unsigned* AB = (unsigned*)(ws + WS_AB); bf16* WD = (bf16*)(ws + WS_WD); bf16* V = (bf16*)(ws + WS_V); bf16* YC = (bf16*)(ws + WS_YCAT);
    constexpr int AL = 264;
    constexpr int VP = 136;
    LAS bf16* Alow = (LAS bf16*)lds;
    LAS bf16* Vt = (LAS bf16*)lds;
    LAS float* par = (LAS float*)(lds + 128 * AL * 2) + wave * 448;
    const int lane_in = lane;
    for (int unit = blockIdx.x; unit < M / 128; unit += gridDim.x) {
        int oz = 0; asm volatile("" : "+v"(oz));
        const int lane = lane_in + oz, tid = wave * 64 + lane, fr = lane & 15, fq = lane >> 4;
        const int t0 = unit * 128; const bool seq_start = (t0 % SEQ) == 0;
        { const int c = 64 * wave + lane;
          par[lane] = mu[c]; par[64 + lane] = mu[512 + c]; par[128 + lane] = mu[1024 + c]; par[192 + lane] = a.in[8][c]; par[256 + lane] = a.in[10][c]; par[320 + lane] = a.in[13][c]; par[384 + lane] = a.in[14][c]; }
        { v4u wst[4]; mp_stage_load(wst, wupT, aupT, gupT, 0, tid); mp_stage_store(wst, (LAS bf16*)(lds + 81920), tid); }
        { const int cg8 = tid & 31, col = 1536 + 8 * cg8;
          const f32x4 m0 = *(const f32x4*)(mu + col), m1 = *(const f32x4*)(mu + col + 4);
          const float mm[8] = {m0.x, m0.y, m0.z, m0.w, m1.x, m1.y, m1.z, m1.w};
          v4u cu[8], pu[8];
#pragma unroll
          for (int pass = 0; pass < 8; ++pass) { const int row = pass * 16 + (tid >> 5); const size_t off = (size_t)(t0 + row) * DIN + col;
              cu[pass] = *(const v4u*)(P + off); pu[pass] = *(const v4u*)(P + ((row == 0 && seq_start) ? off : off - DIN)); }
#pragma unroll
          for (int pass = 0; pass < 8; ++pass) { const int row = pass * 16 + (tid >> 5); const float keep = (row == 0 && seq_start) ? 0.f : 1.f;
              const unsigned cw[4] = {cu[pass].x, cu[pass].y, cu[pass].z, cu[pass].w}, pw[4] = {pu[pass].x, pu[pass].y, pu[pass].z, pu[pass].w}; float c[8];
#pragma unroll
              for (int i = 0; i < 8; ++i) { const float cv = (i & 1) ? bf_hi(cw[i >> 1]) : bf_lo(cw[i >> 1]), qv = ((i & 1) ? bf_hi(pw[i >> 1]) : bf_lo(pw[i >> 1])) * keep;
                  float v = cv + (qv - cv) * mm[i];
                  if (cg8 < 8) v = 1.0f - 2.0f * __builtin_amdgcn_rcpf(__expf(2.0f * v) + 1.0f); else if (cg8 >= 16) v = sigmoidf(v);
                  c[i] = v; }
              v4u o; o.x = pk(c[0], c[1]); o.y = pk(c[2], c[3]); o.z = pk(c[4], c[5]); o.w = pk(c[6], c[7]);
              *(LAS v4u*)(Alow + row * AL + 8 * cg8) = o; } }
        { const int cg8 = tid & 63, col = 1024 + 8 * cg8;
          const f32x4 m0 = *(const f32x4*)(mu + col), m1 = *(const f32x4*)(mu + col + 4);
          const float mm[8] = {m0.x, m0.y, m0.z, m0.w, m1.x, m1.y, m1.z, m1.w};
#pragma unroll
          for (int half = 0; half < 2; ++half) { v4u cu[8], pu[8];
#pragma unroll
              for (int pass = 0; pass < 8; ++pass) { const int row = (half * 8 + pass) * 8 + (tid >> 6); const size_t off = (size_t)(t0 + row) * DIN + col;
                  cu[pass] = *(const v4u*)(P + off); pu[pass] = *(const v4u*)(P + ((row == 0 && seq_start) ? off : off - DIN)); }
#pragma unroll
              for (int pass = 0; pass < 8; ++pass) { const int row = (half * 8 + pass) * 8 + (tid >> 6); const float keep = (row == 0 && seq_start) ? 0.f : 1.f;
                  const unsigned cw[4] = {cu[pass].x, cu[pass].y, cu[pass].z, cu[pass].w}, pw[4] = {pu[pass].x, pu[pass].y, pu[pass].z, pu[pass].w}; float c[8];
#pragma unroll
                  for (int i = 0; i < 8; ++i) { const float cv = (i & 1) ? bf_hi(cw[i >> 1]) : bf_lo(cw[i >> 1]), qv = ((i & 1) ? bf_hi(pw[i >> 1]) : bf_lo(pw[i >> 1])) * keep; c[i] = cv + (qv - cv) * mm[i]; }
                  v4u o; o.x = pk(c[0], c[1]); o.y = pk(c[2], c[3]); o.z = pk(c[4], c[5]); o.w = pk(c[6], c[7]);
                  *(v4u*)(V + (size_t)(t0 + row) * RW + 8 * cg8) = o; } } }
        __syncthreads();
        { const int tb = wave; PV pv[4]; v2u kraw[4]; float inv; v2u rvp[4]; f32x4 rkv[4]; float* BON = a.out + 16 * 1048576;
          const LAS float* par0 = (const LAS float*)(lds + 128 * AL * 2);
          LAS bf16* wbuf = (LAS bf16*)(lds + 81920);
          mp_load_pv(pv, P, a.in[15], t0, seq_start, tb, 0, fr, fq);
          for (int h = 0; h < 8; ++h) {
              v4u wst[4]; const int hn = h + 1 < 8 ? h + 1 : 7;
              mp_stage_load(wst, wupT, aupT, gupT, hn, tid);
              mp_a1_pre(pv, par0 + h * 448, t0, seq_start, tb, h, fr, fq, RB, kraw, rvp, rkv, inv);
              mp_load_pv(pv, P, a.in[15], t0, seq_start, tb, hn, fr, fq);
              mp_a1_main(kraw, rvp, rkv, BON, inv, Alow, par0 + h * 448, wbuf + (h & 1) * 17920, t0, tb, h, fr, fq, K2, AB, WD, YC);
              mp_stage_store(wst, wbuf + ((h + 1) & 1) * 17920, tid);
              asm volatile("s_waitcnt lgkmcnt(0)" ::: "memory"); __builtin_amdgcn_s_barrier(); asm volatile("" ::: "memory");
          } }
        __syncthreads();
        { f32x4 lg0 = *(const f32x4*)(a.in[18] + 8 * lane), lg1 = *(const f32x4*)(a.in[18] + 8 * lane + 4), lb0 = *(const f32x4*)(a.in[19] + 8 * lane), lb1 = *(const f32x4*)(a.in[19] + 8 * lane + 4);
          const float lg[8] = {lg0.x, lg0.y, lg0.z, lg0.w, lg1.x, lg1.y, lg1.z, lg1.w}, lb[8] = {lb0.x, lb0.y, lb0.z, lb0.w, lb1.x, lb1.y, lb1.z, lb1.w};
#pragma unroll 1
          for (int half = 0; half < 2; ++half) {
          v4u pvv[8];
#pragma unroll
          for (int i = 0; i < 8; ++i) pvv[i] = __builtin_nontemporal_load((const v4u*)(P + (size_t)(t0 + 16 * wave + 8 * half + i) * DIN + 2304 + 8 * lane));
#pragma unroll
          for (int i = 0; i < 8; ++i) { const int s = 16 * wave + 8 * half + i; const v4u u = pvv[i];
              float x[8] = {bf_lo(u.x), bf_hi(u.x), bf_lo(u.y), bf_hi(u.y), bf_lo(u.z), bf_hi(u.z), bf_lo(u.w), bf_hi(u.w)}; float sm = 0.f;
#pragma unroll
              for (int j = 0; j < 8; ++j) { x[j] = gelu_as(x[j]); sm += x[j]; }
              const float mean = wave_sum(sm) * (1.0f / 512.0f); float sq = 0.f;
#pragma unroll
              for (int j = 0; j < 8; ++j) { x[j] -= mean; sq += x[j] * x[j]; }
              const float rs = __builtin_amdgcn_rsqf(wave_sum(sq) * (1.0f / 512.0f) + LN_EPS);
#pragma unroll
              for (int j = 0; j < 8; j += 2) { const unsigned w2 = pk(x[j] * rs * lg[j] + lb[j], x[j + 1] * rs * lg[j + 1] + lb[j + 1]);
                  Vt[(j * 65 + lane) * VP + s] = (bf16)(w2 & 0xffffu); Vt[((j + 1) * 65 + lane) * VP + s] = (bf16)(w2 >> 16); }
          } } }
        __syncthreads();
        { const int g = wave; const float* sb = a.in[21]; B1L LA, LB;
          mp_load_b1(LA, P, Wc, sb, t0, 0, g, fr, fq);
#pragma unroll
          for (int tb = 0; tb < 8; tb += 2) {
              mp_load_b1(LB, P, Wc, sb, t0, tb + 1, g, fr, fq);
              mp_b1_body(LA, Vt, YC, t0, tb, g, fr, fq);
              if (tb + 2 < 8) mp_load_b1(LA, P, Wc, sb, t0, tb + 2, g, fr, fq);
              mp_b1_body(LB, Vt, YC, t0, tb + 1, g, fr, fq);
          } }
        __syncthreads();
    }
}

__device__ __forceinline__ bf16 to_bf16(float x) { return (bf16)(pk(x, 0.f) & 0xffffu); }
__device__ __forceinline__ void chunk_prep(const Args& a, LAS unsigned char* lds, int wave, int lane) {
    unsigned char* ws = a.ws;
    const bf16* RB = (const bf16*)(ws + WS_RK); const bf16* K2 = (const bf16*)(ws + WS_RK + 32 * MiB); const unsigned* AB = (const unsigned*)(ws + WS_AB); const bf16* LW = (const bf16*)(ws + WS_WD); const bf16* V = (const bf16*)(ws + WS_V);
    unsigned char* OPS = ws + WS_P; float* GAM = (float*)(ws + WS_GAM);
    LAS unsigned char* L = lds + wave * 16384;
    LAS bf16* tA = (LAS bf16*)L; LAS bf16* tB = tA + 16 * 72; LAS bf16* tK = tB + 16 * 72; LAS bf16* tR = tK + 16 * 72;
    LAS float* coef = (LAS float*)(L + 9216);
    LAS bf16* stage = (LAS bf16*)(L + 13312);
    LAS bf16* nm = (LAS bf16*)(L + 15360);
    const int fr = lane & 15, fq = lane >> 4;
    const int gw = blockIdx.x * NWAVES + wave, NGW = gridDim.x * NWAVES;
    const int j5 = lane & 31, pos = (lane & 32) + ((j5 >> 2) & 3) * 8 + (((j5 >> 4) << 2) | (j5 & 3));
    unsigned short rr[16], kk[16], vv[16], lw[16]; unsigned ab[16];
#define CP_LOAD(task_) do { const int h_ = (task_) & 7, c_ = ((task_) >> 3) & 255, bq_ = (task_) >> 11; const size_t b_ = ((size_t)bq_ * SEQ + c_ * 16) * RW + h_ * 64 + lane; \
        _Pragma("unroll") for (int t = 0; t < 16; ++t) { rr[t] = __builtin_nontemporal_load(RB + b_ + (size_t)t * RW); kk[t] = __builtin_nontemporal_load(K2 + b_ + (size_t)t * RW); ab[t] = __builtin_nontemporal_load(AB + b_ + (size_t)t * RW); lw[t] = __builtin_nontemporal_load(LW + b_ + (size_t)t * RW); vv[t] = V[b_ + (size_t)t * RW]; }     } while (0)
    if (gw < 16384) CP_LOAD(gw);
    for (int task = gw; task < 16384; task += NGW) {
        const int slot = ((((task >> 11) << 3) | (task & 7)) << 8) | ((task >> 3) & 255);
        unsigned char* op = OPS + (size_t)slot * OPS_BYTES;
        v4u bk[4]; v2u vq[4]; float E = 1.f;
        { float cum = 0.f;
#pragma unroll
          for (int q = 0; q < 4; ++q) { float Bq[4], Kq[4];
#pragma unroll
              for (int e = 0; e < 4; ++e) { const int t = 4 * q + e;
                  const float af = bf_lo(ab[t]), bfv = bf_hi(ab[t]), rf = __uint_as_float((unsigned)rr[t] << 16), kf = __uint_as_float((unsigned)kk[t] << 16);
                  const float At = af * E; cum += __uint_as_float((unsigned)lw[t] << 16); E = __expf(cum); const float Ei = __builtin_amdgcn_rcpf(E);
                  Bq[e] = bfv * Ei; Kq[e] = kf * Ei; const float Rt = rf * E;
                  tA[t * 72 + lane] = to_bf16(At); tR[t * 72 + lane] = to_bf16(Rt); }
              const v4u o = (v4u){pk(Bq[0], Bq[1]), pk(Bq[2], Bq[3]), pk(Kq[0], Kq[1]), pk(Kq[2], Kq[3])}; bk[q] = o;
#pragma unroll
              for (int e = 0; e < 4; ++e) { const unsigned w2 = (e < 2) ? (e == 0 ? o.x : o.x >> 16) : (e == 2 ? o.y : o.y >> 16); const unsigned k2 = (e < 2) ? (e == 0 ? o.z : o.z >> 16) : (e == 2 ? o.w : o.w >> 16);
                  tB[(4 * q + e) * 72 + lane] = (bf16)(w2 & 0xffffu); tK[(4 * q + e) * 72 + lane] = (bf16)(k2 & 0xffffu); }
              vq[q].x = (unsigned)vv[4 * q] | ((unsigned)vv[4 * q + 1] << 16); vq[q].y = (unsigned)vv[4 * q + 2] | ((unsigned)vv[4 * q + 3] << 16); } }
        asm volatile("" ::: "memory");
        { const int tn = task + NGW < 16384 ? task + NGW : task; CP_LOAD(tn); }
        asm volatile("" ::: "memory");
#pragma unroll
        for (int q = 0; q < 4; ++q) { *(v4u*)(op + OP_BK + lane * 64 + q * 16) = bk[q]; *(v2u*)(op + OP_V + (((lane >> 4) * 4 + q) * 16 + (lane & 15)) * 8) = vq[q]; }
        GAM[(size_t)slot * 64 + lane] = E;
        LDS_WAIT(); asm volatile("" ::: "memory");
        { f32x4 nab = (f32x4){0.f, 0.f, 0.f, 0.f}, nak = nab, mbr = nab, mkr = nab;
#pragma unroll
          for (int ks = 0; ks < 2; ++ks) { const int o = fr * 72 + ks * 32 + fq * 8;
              const bf16x8 fB = *(const LAS bf16x8*)(tB + o), fK = *(const LAS bf16x8*)(tK + o), gA = *(const LAS bf16x8*)(tA + o), gR = *(const LAS bf16x8*)(tR + o);
              nab = __builtin_amdgcn_mfma_f32_16x16x32_bf16(fB, gA, nab, 0, 0, 0); nak = __builtin_amdgcn_mfma_f32_16x16x32_bf16(fK, gA, nak, 0, 0, 0);
              mbr = __builtin_amdgcn_mfma_f32_16x16x32_bf16(fB, gR, mbr, 0, 0, 0); mkr = __builtin_amdgcn_mfma_f32_16x16x32_bf16(fK, gR, mkr, 0, 0, 0); }
#pragma unroll
          for (int jj = 0; jj < 4; ++jj) { const int tau = 4 * fq + jj;
              coef[0 * 256 + tau * 16 + fr] = tau < fr ? nab[jj] : 0.f; coef[1 * 256 + tau * 16 + fr] = tau < fr ? nak[jj] : 0.f;
              coef[2 * 256 + tau * 16 + fr] = tau <= fr ? mbr[jj] : 0.f; coef[3 * 256 + tau * 16 + fr] = tau <= fr ? mkr[jj] : 0.f; } }
        LDS_WAIT(); asm volatile("" ::: "memory");
        float Ap[16], Np[16];
#pragma unroll
        for (int t = 0; t < 16; ++t) { float acc = bf_lo((unsigned)tA[t * 72 + lane]), accn = coef[256 + fr * 16 + t];
#pragma unroll
            for (int tau = 0; tau < t; ++tau) { const float co = coef[tau * 16 + t]; acc = fmaf(co, Ap[tau], acc); accn = fmaf(co, Np[tau], accn); }
            Ap[t] = acc; Np[t] = accn; stage[t * 64 + pos] = to_bf16(acc);
            if (lane < 16) nm[t * 16 + lane] = to_bf16(accn); }
        LDS_WAIT(); asm volatile("" ::: "memory");
        { const v4u x0 = *(const LAS v4u*)((const LAS unsigned char*)stage + lane * 16), x1 = *(const LAS v4u*)((const LAS unsigned char*)stage + 1024 + lane * 16);
          *(v4u*)(op + OP_A + lane * 16) = x0; *(v4u*)(op + OP_A + 1024 + lane * 16) = x1; }
        LDS_WAIT(); asm volatile("" ::: "memory");
#pragma unroll
        for (int t = 0; t < 16; ++t) { float acc = bf_lo((unsigned)tR[t * 72 + lane]), accm = coef[768 + fr * 16 + t];
#pragma unroll
            for (int tau = 0; tau <= t; ++tau) { const float co = coef[512 + tau * 16 + t]; acc = fmaf(co, Ap[tau], acc); accm = fmaf(co, Np[tau], accm); }
            stage[t * 64 + pos] = to_bf16(acc);
            if (lane < 16) nm[256 + t * 16 + lane] = to_bf16(accm); }
        LDS_WAIT(); asm volatile("" ::: "memory");
        { const v4u x0 = *(const LAS v4u*)((const LAS unsigned char*)stage + lane * 16), x1 = *(const LAS v4u*)((const LAS unsigned char*)stage + 1024 + lane * 16);
          const v4u xn = *(const LAS v4u*)((const LAS unsigned char*)nm + lane * 16);
          *(v4u*)(op + OP_R + lane * 16) = x0; *(v4u*)(op + OP_R + 1024 + lane * 16) = x1; *(v4u*)(op + OP_N + lane * 16) = xn; }
        LDS_WAIT(); asm volatile("" ::: "memory");
    }
}

#undef CP_LOAD
struct ChunkOpsS { v4u a0, a1, bk0, bk1, bk2, bk3; v2u n, v; f32x4 g0, g1, g2, g3; };
struct ChunkOpsY { v4u r0, r1; v2u m, v; };
__device__ __forceinline__ void scan_phase(const Args& a, LAS unsigned char* lds, int wave, int lane) {
    unsigned char* ws = a.ws;
    volatile LAS int* ready = (volatile LAS int*)(lds + 16384); volatile LAS int* consumed = (volatile LAS int*)(lds + 16384 + 256);
    if (wave == 0 && lane == 0) { *ready = 0; *consumed = 0; }
    __syncthreads();
    if (wave < 2) {
        const int fr = lane & 15, fq = lane >> 4; int it = 0;
        for (int blk = blockIdx.x; blk < 256; blk += gridDim.x, ++it) {
            const int task = (gridDim.x == 256) ? (((blk & 7) * 8 + (blk >> 5)) * 4 + ((blk >> 3) & 3)) : blk;
            const int bh = task >> 2, sl = task & 3;
            const unsigned char* op0 = ws + WS_P + (size_t)bh * 256 * OPS_BYTES;
            const int offA = (fr * 64 + fq * 8) * 2, offBK = OP_BK + fr * 64 + fq * 16, offN = OP_N + (fr * 16 + 4 * fq) * 2, offM = OP_M + (fr * 16 + 4 * fq) * 2, offV = OP_V + ((sl * 4 + fq) * 16 + fr) * 8;
#define BX(x) __builtin_bit_cast(bf16x8, (x))
            if (wave == 0) {
                const float* gam0 = (const float*)(ws + WS_GAM) + (size_t)bh * 256 * 64 + 4 * fq;
                f32x4 S0 = (f32x4){0.f, 0.f, 0.f, 0.f}, S1 = S0, S2 = S0, S3 = S0;
                ChunkOpsS A, B;
#define CS_LOAD(X, cc) do { int c_ = (cc); c_ = c_ < 256 ? c_ : 255; const unsigned char* o_ = op0 + (size_t)c_ * OPS_BYTES; const float* g_ = gam0 + c_ * 64; \
                    X.a0 = *(const v4u*)(o_ + OP_A + offA); X.a1 = *(const v4u*)(o_ + OP_A + offA + 64); X.n = *(const v2u*)(o_ + offN); X.v = *(const v2u*)(o_ + offV); \
                    X.bk0 = *(const v4u*)(o_ + offBK); X.bk1 = *(const v4u*)(o_ + offBK + 1024); X.bk2 = *(const v4u*)(o_ + offBK + 2048); X.bk3 = *(const v4u*)(o_ + offBK + 3072); \
                    X.g0 = *(const f32x4*)(g_); X.g1 = *(const f32x4*)(g_ + 16); X.g2 = *(const f32x4*)(g_ + 32); X.g3 = *(const f32x4*)(g_ + 48); } while (0)
#define CS_COMP(X, cc) do { const int g_ = it * 256 + (cc); \
                    const v4u sb0 = (v4u){pk(S0[0], S0[1]), pk(S0[2], S0[3]), pk(S1[0], S1[1]), pk(S1[2], S1[3])}, sb1 = (v4u){pk(S2[0], S2[1]), pk(S2[2], S2[3]), pk(S3[0], S3[1]), pk(S3[2], S3[3])}; \
                    while (g_ - *consumed >= 4) __builtin_amdgcn_s_sleep(1); \
                    { LAS v4u* slot_ = (LAS v4u*)(lds + (g_ & 3) * 2048); slot_[lane] = sb0; slot_[64 + lane] = sb1; } \
                    asm volatile("s_waitcnt lgkmcnt(0)" ::: "memory"); if (lane == 0) *ready = g_ + 1; \
                    const v4u vb = (v4u){X.v.x, X.v.y, 0u, 0u}, nb = (v4u){X.n.x, X.n.y, 0u, 0u}; \
                    f32x4 U = __builtin_amdgcn_mfma_f32_16x16x32_bf16(BX(X.a0), BX(sb0), (f32x4){0.f, 0.f, 0.f, 0.f}, 0, 0, 0); \
                    U = __builtin_amdgcn_mfma_f32_16x16x32_bf16(BX(X.a1), BX(sb1), U, 0, 0, 0); U = __builtin_amdgcn_mfma_f32_16x16x32_bf16(BX(nb), BX(vb), U, 0, 0, 0); \
                    const v4u uv = (v4u){pk(U[0], U[1]), pk(U[2], U[3]), X.v.x, X.v.y}; \
                    S0 = __builtin_amdgcn_mfma_f32_16x16x32_bf16(BX(X.bk0), BX(uv), S0, 0, 0, 0) * X.g0; S1 = __builtin_amdgcn_mfma_f32_16x16x32_bf16(BX(X.bk1), BX(uv), S1, 0, 0, 0) * X.g1; \
                    S2 = __builtin_amdgcn_mfma_f32_16x16x32_bf16(BX(X.bk2), BX(uv), S2, 0, 0, 0) * X.g2; S3 = __builtin_amdgcn_mfma_f32_16x16x32_bf16(BX(X.bk3), BX(uv), S3, 0, 0, 0) * X.g3; } while (0)
                CS_LOAD(A, 0);
                for (int c = 0; c < 256; c += 2) { CS_LOAD(B, c + 1); CS_COMP(A, c); CS_LOAD(A, c + 2); CS_COMP(B, c + 1); }
#undef CS_LOAD
#undef CS_COMP
            } else {
                float* Y = (float*)(ws + WS_WD) + ((size_t)(bh >> 3) * SEQ + 4 * fq) * RW + (bh & 7) * 64 + 16 * sl + fr;
                ChunkOpsY A, B;
#define CY_LOAD(X, cc) do { int c_ = (cc); c_ = c_ < 256 ? c_ : 255; const unsigned char* o_ = op0 + (size_t)c_ * OPS_BYTES; \
                    X.r0 = *(const v4u*)(o_ + OP_R + offA); X.r1 = *(const v4u*)(o_ + OP_R + offA + 64); X.m = *(const v2u*)(o_ + offM); X.v = *(const v2u*)(o_ + offV); } while (0)
#define CY_COMP(X, cc) do { const int g_ = it * 256 + (cc); \
                    while (*ready < g_ + 1) __builtin_amdgcn_s_sleep(1); \
                    const LAS v4u* slot_ = (const LAS v4u*)(lds + (g_ & 3) * 2048); const v4u sb0 = slot_[lane], sb1 = slot_[64 + lane]; \
                    asm volatile("s_waitcnt lgkmcnt(0)" ::: "memory"); if (lane == 0) *consumed = g_ + 1; \
                    const v4u vb = (v4u){X.v.x, X.v.y, 0u, 0u}, mb = (v4u){X.m.x, X.m.y, 0u, 0u}; \
                    f32x4 Yv = __builtin_amdgcn_mfma_f32_16x16x32_bf16(BX(X.r0), BX(sb0), (f32x4){0.f, 0.f, 0.f, 0.f}, 0, 0, 0); \
                    Yv = __builtin_amdgcn_mfma_f32_16x16x32_bf16(BX(X.r1), BX(sb1), Yv, 0, 0, 0); Yv = __builtin_amdgcn_mfma_f32_16x16x32_bf16(BX(mb), BX(vb), Yv, 0, 0, 0); \
                    float* y_ = Y + (size_t)(cc) * 16 * RW; y_[0] = Yv[0]; y_[RW] = Yv[1]; y_[2 * RW] = Yv[2]; y_[3 * RW] = Yv[3]; } while (0)
                CY_LOAD(A, 0);
                for (int c = 0; c < 256; c += 2) { CY_LOAD(B, c + 1); CY_COMP(A, c); CY_LOAD(A, c + 2); CY_COMP(B, c + 1); }
#undef CY_LOAD
#undef CY_COMP
            }
#undef BX
        }
    }
}

__device__ __forceinline__ float grp8_sum(float v) { return pg8::sum_grp8(v); }
__device__ __forceinline__ void post_phase(const Args& a, int wave, int lane) {
    unsigned char* ws = a.ws;
    const float* Y = (const float*)(ws + WS_WD); const bf16* RB = (const bf16*)(ws + WS_RK); const bf16* K2 = (const bf16*)(ws + WS_RK + 32 * MiB); const bf16* V = (const bf16*)(ws + WS_V); bf16* YC = (bf16*)(ws + WS_YCAT);
    const int gw = blockIdx.x * NWAVES + wave, NGW = gridDim.x * NWAVES, c = 8 * lane;
    float gnw[8], gnb[8], rkc[8];
#pragma unroll
    for (int j = 0; j < 8; ++j) { gnw[j] = a.in[16][c + j]; gnb[j] = a.in[17][c + j]; rkc[j] = a.in[15][c + j]; }
    f32x4 y0, y1; v4u vu, gu; float bnl; const float* BON = a.out + 16 * 1048576;
#define POST_LOAD(tt) do { const size_t o_ = (size_t)(tt) * RW + c; y0 = __builtin_nontemporal_load((const f32x4*)(Y + o_)); y1 = __builtin_nontemporal_load((const f32x4*)(Y + o_ + 4)); bnl = BON[(size_t)(tt) * 8 + (lane >> 3)]; vu = *(const v4u*)(V + o_); gu = *(const v4u*)(YC + (size_t)(tt) * D + c); } while (0)
    if (gw < M) POST_LOAD(gw);
    for (int t = gw; t < M; t += NGW) {
        float yv[8] = {y0.x, y0.y, y0.z, y0.w, y1.x, y1.y, y1.z, y1.w};
        const float bn = bnl;
        const float vf[8] = {bf_lo(vu.x), bf_hi(vu.x), bf_lo(vu.y), bf_hi(vu.y), bf_lo(vu.z), bf_hi(vu.z), bf_lo(vu.w), bf_hi(vu.w)};
        const float gf[8] = {bf_lo(gu.x), bf_hi(gu.x), bf_lo(gu.y), bf_hi(gu.y), bf_lo(gu.z), bf_hi(gu.z), bf_lo(gu.w), bf_hi(gu.w)};
        { const int tn = t + NGW < M ? t + NGW : t; POST_LOAD(tn); }
        float sm = 0.f;
#pragma unroll
        for (int j = 0; j < 8; ++j) sm += yv[j];
        const float mean = grp8_sum(sm) * (1.0f / 64.0f); float sq = 0.f;
#pragma unroll
        for (int j = 0; j < 8; ++j) { yv[j] -= mean; sq += yv[j] * yv[j]; }
        const float rs = __builtin_amdgcn_rsqf(grp8_sum(sq) * (1.0f / 64.0f) + GN_EPS);
        float ov[8];
#pragma unroll
        for (int j = 0; j < 8; ++j) ov[j] = (yv[j] * rs * gnw[j] + gnb[j] + bn * vf[j]) * gf[j];
        v4u w; w.x = pk(ov[0], ov[1]); w.y = pk(ov[2], ov[3]); w.z = pk(ov[4], ov[5]); w.w = pk(ov[6], ov[7]);
        *(v4u*)(YC + (size_t)t * D + c) = w;
    }
#undef POST_LOAD
}

__device__ __forceinline__ void final_phase(const Args& a, int wave, int lane) {
    const float* ss = (const float*)(a.ws + WS_SS) + 3 * M; const float* fg = a.in[27]; const bf16* X3 = (const bf16*)(a.ws + WS_WD);
    const int gw = blockIdx.x * NWAVES + wave, NGW = gridDim.x * NWAVES;
    f32x4 g[4];
#pragma unroll
    for (int j = 0; j < 4; ++j) g[j] = *(const f32x4*)(fg + (j >> 1) * 512 + 8 * lane + (j & 1) * 4);
    v4u v[2]; float sv = 0.f;
#define FIN_LOAD(mm) do { const v4u* p_ = (const v4u*)(X3 + (size_t)(mm) * D) + lane; v[0] = __builtin_nontemporal_load(p_); v[1] = __builtin_nontemporal_load(p_ + 64); sv = ss[mm]; } while (0)
    if (gw < M) FIN_LOAD(gw);
    for (int m = gw; m < M; m += NGW) {
        const float rs = __builtin_amdgcn_rsqf(sv * (1.0f / 1024.0f) + RMS_EPS);
        f32x4 o4[4];
#pragma unroll
        for (int h = 0; h < 2; ++h) { o4[2 * h] = (f32x4){bf_lo(v[h].x), bf_hi(v[h].x), bf_lo(v[h].y), bf_hi(v[h].y)} * rs * g[2 * h]; o4[2 * h + 1] = (f32x4){bf_lo(v[h].z), bf_hi(v[h].z), bf_lo(v[h].w), bf_hi(v[h].w)} * rs * g[2 * h + 1]; }
        { const int mn = m + NGW < M ? m + NGW : m; FIN_LOAD(mn); }
        float* o = a.out + (size_t)m * D + 8 * lane;
        __builtin_nontemporal_store(o4[0], (f32x4*)(o)); __builtin_nontemporal_store(o4[1], (f32x4*)(o + 4)); __builtin_nontemporal_store(o4[2], (f32x4*)(o + 512)); __builtin_nontemporal_store(o4[3], (f32x4*)(o + 516));
    }
#undef FIN_LOAD
}

__global__ void __launch_bounds__(NTHREADS, 2) fwd_mega(Args args) {
    extern __shared__ __attribute__((aligned(16))) unsigned char lds_raw[];
    cg::grid_group grid = cg::this_grid();
    LAS unsigned char* lds = (LAS unsigned char*)lds_raw;
    const int wave = __builtin_amdgcn_readfirstlane((int)threadIdx.x >> 6);
#define lane ((int)__builtin_amdgcn_mbcnt_hi(~0u, __builtin_amdgcn_mbcnt_lo(~0u, 0u)))
    unsigned char* ws = args.ws;
    volatile LAS unsigned* xb_st = (volatile LAS unsigned*)(lds + LDS_BYTES - 64);
    if (threadIdx.x < 2) xb_st[threadIdx.x] = 0u;
    __syncthreads();
    const XcdBarrier xbar = xcd_barrier_post((unsigned*)(ws + WS_BAR), xb_st);
    float* ss = (float*)(ws + WS_SS);
    bf16* XB = (bf16*)(ws + WS_WD); bf16* HID = (bf16*)(ws + WS_P); bf16* YC = (bf16*)(ws + WS_YCAT);
    bf16* XS = (bf16*)args.out;
    const int lo = args.ph_lo, hi = args.ph_hi;
#define IN(k) (lo <= (k) && (k) < hi)
#define SEAM(k) do { if (IN(k) && IN((k) + 1)) xcd_barrier(xbar); } while (0)
    if (args.ph_hi > NPHASE) grid.sync();
    if (IN(0)) { p0_prologue(args, lds, wave, lane); __syncthreads(); } SEAM(0);
    if (IN(1)) {
        pg8::Gemm g{XB, (const bf16*)(ws + WS_W13_1), M, NUP, D}; pg8::StaticOrder S; S.init(M, NUP, gridDim.x, blockIdx.x);
        pg8::EpiScaled<1> E{HID, FF, ss, RMS_EPS};
        pg8::gemm_phase<pg8::EpiScaled<1>, pg8::StaticOrder, true, true>(lds, g, S, E, wave); } SEAM(1);
    if (IN(2)) {
        pg8::Gemm g{HID, (const bf16*)(ws + WS_W2_1), M, D, FF}; pg8::StaticOrder S; S.init(M, D, gridDim.x, blockIdx.x);
        pg8::EpiResid E{nullptr, XB, nullptr, XS, ss + M, 0.5f};
        pg8::gemm_phase<pg8::EpiResid, pg8::StaticOrder, true, true>(lds, g, S, E, wave); } SEAM(2);
    if (IN(3)) {
        pg8::Gemm g{XS, (const bf16*)(ws + WS_WIN), M, DIN, D}; pg8::StaticOrder S; S.init(M, DIN, gridDim.x, blockIdx.x);
        pg8::EpiScaled<0> E{HID, DIN, ss + M, RMS_EPS};
        pg8::gemm_phase<pg8::EpiScaled<0>, pg8::StaticOrder, true, true>(lds, g, S, E, wave); } SEAM(3);
    if (IN(4)) { mixer_prep(args, lds, wave, lane); } SEAM(4);
    if (IN(5)) { chunk_prep(args, lds, wave, lane); } SEAM(5);
    if (IN(6)) { scan_phase(args, lds, wave, lane); } SEAM(6);
    if (IN(7)) { post_phase(args, wave, lane); } SEAM(7);
    if (IN(8)) {
        pg8::Gemm g{YC, (const bf16*)(ws + WS_WOUT), M, D, D}; pg8::StaticOrder S; S.init(M, D, gridDim.x, blockIdx.x);
        pg8::EpiResid E{nullptr, XS, nullptr, XS, ss + 2 * M, 1.0f};
        pg8::gemm_phase<pg8::EpiResid, pg8::StaticOrder, true, true>(lds, g, S, E, wave); } SEAM(8);
    if (IN(9)) {
        pg8::Gemm g{XS, (const bf16*)(ws + WS_W13_2), M, NUP, D}; pg8::StaticOrder S; S.init(M, NUP, gridDim.x, blockIdx.x);
        pg8::EpiScaled<1> E{HID, FF, ss + 2 * M, RMS_EPS};
        pg8::gemm_phase<pg8::EpiScaled<1>, pg8::StaticOrder, true, true>(lds, g, S, E, wave); } SEAM(9);
    if (IN(10)) {
        pg8::Gemm g{HID, (const bf16*)(ws + WS_W2_2), M, D, FF}; pg8::StaticOrder S; S.init(M, D, gridDim.x, blockIdx.x);
        pg8::EpiResid E{nullptr, XS, nullptr, XB, ss + 3 * M, 0.5f};
        pg8::gemm_phase<pg8::EpiResid, pg8::StaticOrder, true, true>(lds, g, S, E, wave); } SEAM(10);
    if (IN(11)) { final_phase(args, wave, lane); }
#undef IN
#undef SEAM
#undef lane
}

extern "C" void kernel_launch(void* const* d_in, const int* in_sizes, int n_in, void* d_out, int out_size, void* d_ws, size_t ws_size, hipStream_t stream) {
    static int grid = 0;
    if (grid == 0) {
        if (n_in != 28 || in_sizes[0] != M * D || out_size != M * D || ws_size < WS_END) { fprintf(stderr, "kernel_launch: unexpected shapes: n_in %d in0 %d out %d ws %zu (need %zu)\n", n_in, n_in > 0 ? in_sizes[0] : -1, out_size, ws_size, (size_t)WS_END); grid = -1; return; }
        int dev = 0, cus = 0, per_cu = 0;
        hipGetDevice(&dev); hipDeviceGetAttribute(&cus, hipDeviceAttributeMultiprocessorCount, dev);
        if (hipFuncSetAttribute((const void*)fwd_mega, hipFuncAttributeMaxDynamicSharedMemorySize, LDS_BYTES) != hipSuccess) { fprintf(stderr, "kernel_launch: hipFuncSetAttribute failed\n"); grid = -1; return; }
        if (hipOccupancyMaxActiveBlocksPerMultiprocessor(&per_cu, (const void*)fwd_mega, NTHREADS, LDS_BYTES) != hipSuccess || per_cu < 1) { fprintf(stderr, "kernel_launch: occupancy query says %d blocks per CU\n", per_cu); per_cu = 1; }
        (void)hipGetLastError();
        grid = cus * per_cu; if (grid > 256) grid = 256;
    }
    if (grid < 0) return;
    if (hipMemsetAsync((char*)d_ws + WS_BAR, 0, 16384, stream) != hipSuccess) { fprintf(stderr, "kernel_launch: hipMemsetAsync of the barrier words failed\n"); return; }
    Args a{};
    for (int i = 0; i < 28; ++i) a.in[i] = (const float*)d_in[i];
    a.out = (float*)d_out; a.ws = (unsigned char*)d_ws;
#if MK_SPLIT
    for (int p = 0; p < NPHASE; ++p) { a.ph_lo = p; a.ph_hi = p + 1; void* kargs[] = {&a};
        hipError_t e = hipLaunchCooperativeKernel((const void*)fwd_mega, dim3(grid), dim3(NTHREADS), kargs, LDS_BYTES, stream);
        if (e != hipSuccess) { fprintf(stderr, "kernel_launch: launch of phase %d failed: %s\n", p, hipGetErrorString(e)); break; } }
#else
    a.ph_lo = 0; a.ph_hi = NPHASE; void* kargs[] = {&a};
    hipError_t e = hipLaunchCooperativeKernel((const void*)fwd_mega, dim3(grid), dim3(NTHREADS), kargs, LDS_BYTES, stream);
    if (e != hipSuccess) fprintf(stderr, "kernel_launch: cooperative launch failed: %s (grid %d)\n", hipGetErrorString(e), grid);
#endif
}
```

```cpp
#include <hip/hip_runtime.h>
#include <hip/hip_cooperative_groups.h>
#include <cstdio>
#include <cstdint>
namespace cg = cooperative_groups;
namespace pg8 {
#define PG8_LAS __attribute__((address_space(3)))
typedef unsigned short bf16_t;
typedef short bf16x8 __attribute__((ext_vector_type(8)));
typedef float f32x4 __attribute__((ext_vector_type(4)));
typedef unsigned u32x4 __attribute__((ext_vector_type(4)));
constexpr int BM = 256, BK = 64, HALF = 128, HTB = HALF * BK * 2  , STAGE_BYTES = 8 * HTB, NXCD = 8, WGM = 4;

__host__ __device__ __forceinline__ int lds_byte(int r, int c) { const int st = (r >> 4) * 2 + (c >> 5), rr = r & 15, cc = c & 31, ob = rr * 64 + cc * 2; return st * 1024 + (ob ^ (((ob >> 9) & 1) << 5)); }
__host__ __device__ __forceinline__ void stage_rc(int b, int& R, int& C) { const int st = b / 1024, sb = b % 1024, swz = sb ^ (((sb >> 9) & 1) << 5); R = (st >> 1) * 16 + swz / 64; C = (st & 1) * 32 + (swz % 64) / 2; }
__host__ __device__ __forceinline__ int perm32(int rho) { const int n = rho >> 4, i = rho & 15; return 8 * (i >> 2) + 4 * n + (i & 3); }

struct Unit { int pm, pn; };
struct Gemm { const bf16_t* A; const bf16_t* Bt; int M, N, K; };

struct StaticOrder {
    int nM, nN, nwg, G, c;
    __host__ __device__ void init(int M, int N, int G_, int c_) { nM = M / BM; nN = N / BM; nwg = nM * nN; G = G_; c = c_; }
    __host__ __device__ bool next(int i, Unit& u) const {
        const long L = (long)i * G + c; if (L >= nwg) return false;
        int wgid = (int)L; { const int q = nwg / NXCD, r = nwg % NXCD, xcd = wgid % NXCD, off = wgid / NXCD; wgid = (xcd < r ? xcd * (q + 1) : r * (q + 1) + (xcd - r) * q) + off; }
        const int nig = WGM * nN, gid = wgid / nig, fm = gid * WGM, gsz = (nM - fm) < WGM ? (nM - fm) : WGM;
        u.pm = fm + ((wgid % nig) % gsz); u.pn = (wgid % nig) / gsz; return true;
    }
    __device__ __forceinline__ void a_ready(const Unit&) const {}
    __device__ __forceinline__ void done(const Unit&) const {}
};

typedef __bf16 bf16n2 __attribute__((ext_vector_type(2)));
typedef float f32n2 __attribute__((ext_vector_type(2)));
__device__ __forceinline__ unsigned cvt_pk_bf16(float lo, float hi) { const f32n2 f = {lo, hi}; return __builtin_bit_cast(unsigned, __builtin_convertvector(f, bf16n2)); }
typedef float f32x2 __attribute__((ext_vector_type(2)));
typedef unsigned u32n2 __attribute__((ext_vector_type(2)));
template <int CTRL> __device__ __forceinline__ float dpp_mov(float v) { return __builtin_bit_cast(float, __builtin_amdgcn_update_dpp(0, __builtin_bit_cast(int, v), CTRL, 0xf, 0xf, true)); }
__device__ __forceinline__ float sum_xor16(float v) { float w = v; asm volatile("" : "+v"(w)); const u32n2 r = __builtin_amdgcn_permlane16_swap(__builtin_bit_cast(unsigned, v), __builtin_bit_cast(unsigned, w), false, false);
    unsigned a = r.x, b = r.y; asm volatile("" : "+v"(a), "+v"(b)); return __builtin_bit_cast(float, a) + __builtin_bit_cast(float, b); }
__device__ __forceinline__ float sum_xor32(float v) { float w = v; asm volatile("" : "+v"(w)); const u32n2 r = __builtin_amdgcn_permlane32_swap(__builtin_bit_cast(unsigned, v), __builtin_bit_cast(unsigned, w), false, false);
    unsigned a = r.x, b = r.y; asm volatile("" : "+v"(a), "+v"(b)); return __builtin_bit_cast(float, a) + __builtin_bit_cast(float, b); }
__device__ __forceinline__ float sum_grp8(float v) { v += dpp_mov<0xB1>(v); v += dpp_mov<0x4E>(v); v += dpp_mov<0x141>(v); return v; }
__device__ __forceinline__ float sum_row16(float v) { v = sum_grp8(v); v += dpp_mov<0x140>(v); return v; }
__device__ __forceinline__ float sum_wave(float v) { return sum_xor32(sum_xor16(sum_row16(v))); }
__device__ __forceinline__ float fast_silu(float x) { return x * __builtin_amdgcn_rcpf(1.0f + __expf(-x)); }
template <int MODE> struct EpiScaled {
    static constexpr bool PERM = true, AFTER_DRAIN = false;
    bf16_t* O; int ldc; const float* ss; float eps;
    __device__ __forceinline__ void operator()(const f32x4 (&acc)[2][2][4][2], const Unit& u, int wr, int wc, int fr, int fq) const {
        const int row0 = u.pm * BM + wr * 64 + fr;
#pragma unroll
        for (int ai = 0; ai < 2; ++ai)
#pragma unroll
            for (int m = 0; m < 4; ++m) {
                const int row = row0 + ai * HALF + m * 16;
                const float rs = __builtin_amdgcn_rsqf(ss[row] * (1.0f / 1024.0f) + eps);
                if (MODE == 0) {
                    bf16_t* rowp = O + (size_t)row * ldc + u.pn * BM + wc * 32 + 8 * fq;
#pragma unroll
                    for (int bj = 0; bj < 2; ++bj) { const f32x4 v0 = acc[ai][bj][m][0] * rs, v1 = acc[ai][bj][m][1] * rs;
                        u32x4 w; w.x = cvt_pk_bf16(v0[0], v0[1]); w.y = cvt_pk_bf16(v0[2], v0[3]); w.z = cvt_pk_bf16(v1[0], v1[1]); w.w = cvt_pk_bf16(v1[2], v1[3]);
                        *(u32x4*)(rowp + bj * HALF) = w; }
                } else {
                    bf16_t* rowp = O + (size_t)row * ldc + u.pn * HALF + wc * 32 + 8 * fq;
                    float h[8];
#pragma unroll
                    for (int n = 0; n < 2; ++n)
#pragma unroll
                        for (int j = 0; j < 4; ++j) h[n * 4 + j] = fast_silu(acc[ai][0][m][n][j] * rs) * (acc[ai][1][m][n][j] * rs);
                    u32x4 w; w.x = cvt_pk_bf16(h[0], h[1]); w.y = cvt_pk_bf16(h[2], h[3]); w.z = cvt_pk_bf16(h[4], h[5]); w.w = cvt_pk_bf16(h[6], h[7]);
                    *(u32x4*)rowp = w;
                }
            }
    }
};
struct EpiResid {
    static constexpr bool PERM = true, AFTER_DRAIN = false;
    const float* base; const bf16_t* base16; float* out; bf16_t* xb; float* ss; float scale;
    __device__ __forceinline__ void operator()(const f32x4 (&acc)[2][2][4][2], const Unit& u, int wr, int wc, int fr, int fq) const {
        const int row0 = u.pm * BM + wr * 64 + fr, col0 = u.pn * BM + wc * 32 + 8 * fq;
#pragma unroll
        for (int ai = 0; ai < 2; ++ai) {
            f32x4 bv[4][2][2];
#pragma unroll
            for (int m = 0; m < 4; ++m)
#pragma unroll
                for (int bj = 0; bj < 2; ++bj) { const size_t off = (size_t)(row0 + ai * HALF + m * 16) * 1024 + col0 + bj * HALF;
                    if (base16) { const u32x4 w = *(const u32x4*)(base16 + off);
                        bv[m][bj][0] = (f32x4){__uint_as_float(w.x << 16), __uint_as_float(w.x & 0xffff0000u), __uint_as_float(w.y << 16), __uint_as_float(w.y & 0xffff0000u)};
                        bv[m][bj][1] = (f32x4){__uint_as_float(w.z << 16), __uint_as_float(w.z & 0xffff0000u), __uint_as_float(w.w << 16), __uint_as_float(w.w & 0xffff0000u)}; }
                    else { bv[m][bj][0] = *(const f32x4*)(base + off); bv[m][bj][1] = *(const f32x4*)(base + off + 4); } }
#pragma unroll
            for (int m = 0; m < 4; ++m) {
                const int row = row0 + ai * HALF + m * 16; float sq = 0.f;
#pragma unroll
                for (int bj = 0; bj < 2; ++bj) { const size_t off = (size_t)row * 1024 + col0 + bj * HALF;
                    const f32x4 o0 = bv[m][bj][0] + acc[ai][bj][m][0] * scale, o1 = bv[m][bj][1] + acc[ai][bj][m][1] * scale;
                    if (out) { *(f32x4*)(out + off) = o0; *(f32x4*)(out + off + 4) = o1; }
                    if (xb) { u32x4 w; w.x = cvt_pk_bf16(o0[0], o0[1]); w.y = cvt_pk_bf16(o0[2], o0[3]); w.z = cvt_pk_bf16(o1[0], o1[1]); w.w = cvt_pk_bf16(o1[2], o1[3]); *(u32x4*)(xb + off) = w; }
                    sq += (o0[0] * o0[0] + o0[1] * o0[1]) + (o0[2] * o0[2] + o0[3] * o0[3]) + (o1[0] * o1[0] + o1[1] * o1[1]) + (o1[2] * o1[2] + o1[3] * o1[3]); }
                sq = sum_xor32(sum_xor16(sq));
                if (fq == 0) atomicAdd(ss + row, sq);
            }
        }
    }
};
template <class Epi, class Sched, bool ALIGN_EPI = false, bool SP2 = false>
__device__ __forceinline__ void gemm_phase(PG8_LAS unsigned char* lds, const Gemm g, const Sched& S, const Epi& E, const int wid_in) {
    const int wid = wid_in, lane = (int)__builtin_amdgcn_mbcnt_hi(~0u, __builtin_amdgcn_mbcnt_lo(~0u, 0u)), tid = wid * 64 + lane, wr = wid >> 2, wc = wid & 3, fr = lane & 15, fq = lane >> 4;
    const int K = g.K, nt = K / BK;
    unsigned voffA[2], voffB[2];
#pragma unroll
    for (int i = 0; i < 2; ++i) { int R, C; stage_rc(tid * 16 + i * 8192, R, C); const int Rb = Epi::PERM ? ((R & ~31) + perm32(R & 31)) : R;
        voffA[i] = (unsigned)(R * K + C) * 2u; voffB[i] = (unsigned)(Rb * K + C) * 2u; }
    const size_t kstep = (size_t)(BK * 2);
    const size_t hstep = (size_t)HALF * K * 2;
    const size_t tstep = 2 * hstep;
    const unsigned ldsw = (unsigned)wid * 1024u;
    const int aoff = lds_byte(wr * 64 + fr, fq * 8), boff = lds_byte(wc * 32 + fr, fq * 8);
#define PG8_SA(b, h) (((b) * 2 + (h)) * HTB)
#define PG8_SB(b, h) ((4 + (b) * 2 + (h)) * HTB)
#define PG8_STAGE(bufoff, gbase, voff) do { _Pragma("unroll") for (int _i = 0; _i < 2; ++_i) \
        __builtin_amdgcn_global_load_lds((const unsigned*)((const char*)(gbase) + (voff)[_i]), (PG8_LAS unsigned*)(lds + (bufoff) + ldsw + _i * 8192), 16, 0, 0); } while (0)
#define PG8_LDA(dst, b, h) do { _Pragma("unroll") for (int m = 0; m < 4; ++m) _Pragma("unroll") for (int k = 0; k < 2; ++k) dst[m][k] = *(const PG8_LAS bf16x8*)(lds + PG8_SA(b, h) + aoff + m * 2048 + k * 1024); } while (0)
#define PG8_LDB(dst, b, h) do { _Pragma("unroll") for (int n = 0; n < 2; ++n) _Pragma("unroll") for (int k = 0; k < 2; ++k) dst[n][k] = *(const PG8_LAS bf16x8*)(lds + PG8_SB(b, h) + boff + n * 2048 + k * 1024); } while (0)
#define PG8_MMA(ai, bj, At, Bt) do { __builtin_amdgcn_s_setprio(1); _Pragma("unroll") for (int m = 0; m < 4; ++m) _Pragma("unroll") for (int n = 0; n < 2; ++n) _Pragma("unroll") for (int k = 0; k < 2; ++k) \
        acc[ai][bj][m][n] = __builtin_amdgcn_mfma_f32_16x16x32_bf16(Bt[n][k], At[m][k], acc[ai][bj][m][n], 0, 0, 0); __builtin_amdgcn_s_setprio(0); } while (0)
#define PG8_WAIT_V(n) asm volatile("s_waitcnt vmcnt(" #n ")" ::: "memory")
#define PG8_WAIT_L(n) asm volatile("s_waitcnt lgkmcnt(" #n ")" ::: "memory")
#define PG8_BAR __builtin_amdgcn_s_barrier()
#define PG8_SCHED __builtin_amdgcn_sched_barrier(0)
    Unit cur, nxt; int ui = 0;
    if (!S.next(0, cur)) return;
    f32x4 acc[2][2][4][2];
#pragma unroll
    for (int a = 0; a < 2; ++a)
#pragma unroll
        for (int b = 0; b < 2; ++b)
#pragma unroll
            for (int m = 0; m < 4; ++m)
#pragma unroll
                for (int n = 0; n < 2; ++n) acc[a][b][m][n] = (f32x4){0.f, 0.f, 0.f, 0.f};
    bf16x8 At[4][2], B0[2][2], B1[2][2];
    const char* cA = (const char*)g.A + (size_t)cur.pm * tstep; const char* cB = (const char*)g.Bt + (size_t)cur.pn * tstep;
    S.a_ready(cur);
    if constexpr (SP2) {
        PG8_STAGE(PG8_SB(0, 0), cB, voffB); PG8_STAGE(PG8_SB(0, 1), cB + hstep, voffB); PG8_STAGE(PG8_SA(0, 0), cA, voffA); PG8_STAGE(PG8_SA(0, 1), cA + hstep, voffA);
        if (wr == 1) PG8_BAR;
        PG8_WAIT_V(2); PG8_BAR;
        PG8_STAGE(PG8_SB(1, 0), cB + kstep, voffB); PG8_STAGE(PG8_SA(1, 0), cA + kstep, voffA); PG8_STAGE(PG8_SB(1, 1), cB + hstep + kstep, voffB);
        PG8_WAIT_V(6); PG8_BAR;
    } else {
        PG8_STAGE(PG8_SB(0, 0), cB, voffB); PG8_STAGE(PG8_SA(0, 0), cA, voffA); PG8_STAGE(PG8_SB(0, 1), cB + hstep, voffB); PG8_STAGE(PG8_SA(0, 1), cA + hstep, voffA);
        if (wr == 1) PG8_BAR;
        PG8_WAIT_V(4); PG8_BAR;
        PG8_STAGE(PG8_SB(1, 0), cB + kstep, voffB); PG8_STAGE(PG8_SA(1, 0), cA + kstep, voffA); PG8_STAGE(PG8_SB(1, 1), cB + hstep + kstep, voffB);
        PG8_WAIT_V(6); PG8_BAR;
    }
    for (;;) {
        const bool has_next = S.next(ui + 1, nxt);
        const char* nA = has_next ? (const char*)g.A + (size_t)nxt.pm * tstep : cA; const char* nB = has_next ? (const char*)g.Bt + (size_t)nxt.pn * tstep : cB;
        for (int t = 0; t < nt; t += 2) {
            const bool last = (t == nt - 2);
            const char* a1 = cA + (size_t)(t + 1) * kstep;
            const char* a2 = last ? nA : cA + (size_t)(t + 2) * kstep; const char* b2 = last ? nB : cB + (size_t)(t + 2) * kstep;
            const char* a3 = a2 + kstep; const char* b3 = b2 + kstep;
            if (last && has_next) S.a_ready(nxt);
            if constexpr (SP2) {
            PG8_LDB(B0, 0, 0); PG8_LDB(B1, 0, 1); PG8_SCHED; PG8_LDA(At, 0, 0); PG8_STAGE(PG8_SA(1, 1), a1 + hstep, voffA);
            PG8_WAIT_V(8); PG8_WAIT_L(0); PG8_BAR; PG8_MMA(0, 0, At, B0); PG8_MMA(0, 1, At, B1); PG8_BAR; PG8_SCHED;
            PG8_LDA(At, 0, 1); PG8_STAGE(PG8_SB(0, 0), b2, voffB); PG8_STAGE(PG8_SB(0, 1), b2 + hstep, voffB); PG8_STAGE(PG8_SA(0, 0), a2, voffA);
            PG8_WAIT_V(8); PG8_WAIT_L(0); PG8_BAR; PG8_MMA(1, 0, At, B0); PG8_MMA(1, 1, At, B1); PG8_BAR; PG8_SCHED;
            PG8_LDB(B0, 1, 0); PG8_LDB(B1, 1, 1); PG8_SCHED; PG8_LDA(At, 1, 0); PG8_STAGE(PG8_SA(0, 1), a2 + hstep, voffA);
            PG8_WAIT_V(8); PG8_WAIT_L(0); PG8_BAR; PG8_MMA(0, 0, At, B0); PG8_MMA(0, 1, At, B1); PG8_BAR; PG8_SCHED;
            PG8_LDA(At, 1, 1); PG8_STAGE(PG8_SB(1, 0), b3, voffB); PG8_STAGE(PG8_SB(1, 1), b3 + hstep, voffB); PG8_STAGE(PG8_SA(1, 0), a3, voffA);
            PG8_WAIT_V(8); PG8_WAIT_L(0); PG8_BAR; PG8_MMA(1, 0, At, B0); PG8_MMA(1, 1, At, B1); PG8_BAR; PG8_SCHED;
            } else {
            PG8_LDB(B0, 0, 0); PG8_SCHED; PG8_LDA(At, 0, 0); PG8_STAGE(PG8_SA(1, 1), a1 + hstep, voffA);
            PG8_WAIT_L(8); PG8_BAR; PG8_WAIT_L(0); PG8_MMA(0, 0, At, B0); PG8_BAR; PG8_SCHED;
            PG8_LDB(B1, 0, 1); PG8_STAGE(PG8_SB(0, 0), b2, voffB);
            PG8_BAR; PG8_WAIT_L(0); PG8_MMA(0, 1, At, B1); PG8_BAR;
            PG8_LDA(At, 0, 1); PG8_STAGE(PG8_SA(0, 0), a2, voffA);
            PG8_BAR; PG8_WAIT_L(0); PG8_MMA(1, 0, At, B0); PG8_BAR; PG8_SCHED;
            PG8_STAGE(PG8_SB(0, 1), b2 + hstep, voffB);
            PG8_WAIT_V(6); PG8_BAR; PG8_MMA(1, 1, At, B1); PG8_BAR;
            PG8_LDB(B0, 1, 0); PG8_SCHED; PG8_LDA(At, 1, 0); PG8_STAGE(PG8_SA(0, 1), a2 + hstep, voffA);
            PG8_WAIT_L(8); PG8_BAR; PG8_WAIT_L(0); PG8_MMA(0, 0, At, B0); PG8_BAR; PG8_SCHED;
            PG8_LDB(B1, 1, 1); PG8_STAGE(PG8_SB(1, 0), b3, voffB);
            PG8_BAR; PG8_WAIT_L(0); PG8_MMA(0, 1, At, B1); PG8_BAR;
            PG8_LDA(At, 1, 1); PG8_STAGE(PG8_SA(1, 0), a3, voffA);
            PG8_BAR; PG8_WAIT_L(0); PG8_MMA(1, 0, At, B0); PG8_BAR; PG8_SCHED;
            PG8_STAGE(PG8_SB(1, 1), b3 + hstep, voffB);
            PG8_WAIT_V(6); PG8_BAR; PG8_MMA(1, 1, At, B1); PG8_BAR;
            }
        }
        if constexpr (ALIGN_EPI) { if (wr == 0) PG8_BAR; }
        if constexpr (!Epi::AFTER_DRAIN) { E(acc, cur, wr, wc, fr, fq); S.done(cur); }
        if (!has_next) break;
#pragma unroll
        for (int a = 0; a < 2; ++a)
#pragma unroll
            for (int b = 0; b < 2; ++b)
#pragma unroll
                for (int m = 0; m < 4; ++m)
#pragma unroll
                    for (int n = 0; n < 2; ++n) acc[a][b][m][n] = (f32x4){0.f, 0.f, 0.f, 0.f};
        cur = nxt; cA = nA; cB = nB; ++ui;
        if constexpr (ALIGN_EPI) { if (wr == 1) PG8_BAR; }
    }
    PG8_WAIT_V(0);
    if constexpr (!ALIGN_EPI) { if (wr == 0) PG8_BAR; }
    PG8_BAR;
    if constexpr (Epi::AFTER_DRAIN) { E.fused(acc, cur, wr, wc, fr, fq, lds, wid, lane); S.done(cur); }
#undef PG8_SA
#undef PG8_SB
#undef PG8_STAGE
#undef PG8_LDA
#undef PG8_LDB
#undef PG8_MMA
#undef PG8_WAIT_V
#undef PG8_WAIT_L
#undef PG8_BAR
#undef PG8_SCHED
}
}

#ifndef MK_SPLIT
#define MK_SPLIT 0
#endif
#define LAS __attribute__((address_space(3)))
typedef unsigned short bf16;
typedef unsigned v4u __attribute__((ext_vector_type(4)));
typedef unsigned v2u __attribute__((ext_vector_type(2)));
typedef float f32x4 __attribute__((ext_vector_type(4)));
typedef short bf16x8 __attribute__((ext_vector_type(8)));

constexpr int NWAVES = 8, NTHREADS = 512;
constexpr int M = 32768, SEQ = 4096, D = 1024, FF = 2816, NUP = 5632, DIN = 2816, RW = 512, NPHASE = 12;
constexpr float RMS_EPS = 1e-6f, GN_EPS = 64e-5f, LN_EPS = 1e-5f;
constexpr size_t MiB = 1u << 20;
constexpr size_t WS_W13_1 = 0, WS_W2_1 = 11 * MiB, WS_W13_2 = 17 * MiB, WS_W2_2 = 28 * MiB, WS_WIN = 34 * MiB, WS_WOUT = 40 * MiB,
    WS_WUPT = 42 * MiB, WS_AUPT = 42 * MiB + 65536, WS_GUPT = 42 * MiB + 131072, WS_WC = 42 * MiB + 262144, WS_SS = 43 * MiB, WS_BAR = 43 * MiB + 786432  ,
    WS_P = 44 * MiB  , WS_RK = 220 * MiB, WS_AB = 284 * MiB, WS_WD = 348 * MiB  , WS_V = 412 * MiB,
    WS_YCAT = 444 * MiB, WS_GAM = 508 * MiB  , WS_END = 512 * MiB;
constexpr int OPS_BYTES = 11264, OP_A = 0, OP_R = 2048, OP_BK = 4096, OP_N = 8192, OP_M = 8704, OP_V = 9216;
constexpr int LDS_BYTES = 153856;

#define LDS_WAIT() asm volatile("s_waitcnt lgkmcnt(0)" ::: "memory")
__device__ __forceinline__ float bf_lo(unsigned u) { return __uint_as_float(u << 16); }
__device__ __forceinline__ float bf_hi(unsigned u) { return __uint_as_float(u & 0xffff0000u); }
__device__ __forceinline__ unsigned pk(float lo, float hi) { return pg8::cvt_pk_bf16(lo, hi); }
__device__ __forceinline__ float wave_sum(float v) { return pg8::sum_wave(v); }
__device__ __forceinline__ float gelu_erf(float x) { return 0.5f * x * (1.0f + erff(x * 0.70710678118654752f)); }
__device__ __forceinline__ float sigmoidf(float x) { return __builtin_amdgcn_rcpf(1.0f + __expf(-x)); }

struct TItem { const float* W; bf16* WT; const float* gk; int K, N, mode, item; };
__device__ __forceinline__ void titem_load(const TItem& ti, float (&v)[32], int lane) {
    const int nblk = ti.N / 32, kb = ti.item / nblk, nb = ti.item % nblk;
    const float* src = ti.W + (size_t)(64 * kb + (lane >> 5)) * ti.N + 32 * nb + (lane & 31);
#pragma unroll
    for (int i = 0; i < 32; ++i) v[i] = __builtin_nontemporal_load(src + (size_t)(2 * i) * ti.N);
}
__device__ __forceinline__ void titem_store(const TItem& ti, const float (&v)[32], LAS float* scr, int lane) {
    const int nblk = ti.N / 32, kb = ti.item / nblk, nb = ti.item % nblk, k0 = 64 * kb, n0 = 32 * nb;
#pragma unroll
    for (int i = 0; i < 32; ++i) scr[(2 * i + (lane >> 5)) * 33 + (lane & 31)] = v[i];
    LDS_WAIT(); asm volatile("" ::: "memory");
    const int c = lane & 7;
    f32x4 g0 = (f32x4){1.f, 1.f, 1.f, 1.f}, g1 = g0;
    if (ti.gk) { g0 = *(const f32x4*)(ti.gk + k0 + 8 * c); g1 = *(const f32x4*)(ti.gk + k0 + 8 * c + 4); }
    const int d0 = (ti.mode == 0) ? n0 : ((n0 >> 7) * 256 + (n0 & 127) + (ti.mode == 2 ? 128 : 0));
#pragma unroll
    for (int j = 0; j < 4; ++j) { const int n = (lane >> 3) + 8 * j; const LAS float* sp = scr + (8 * c) * 33 + n;
        v4u o; o.x = pk(sp[0 * 33] * g0.x, sp[1 * 33] * g0.y); o.y = pk(sp[2 * 33] * g0.z, sp[3 * 33] * g0.w); o.z = pk(sp[4 * 33] * g1.x, sp[5 * 33] * g1.y); o.w = pk(sp[6 * 33] * g1.z, sp[7 * 33] * g1.w);
        *(v4u*)(ti.WT + (size_t)(d0 + n) * ti.K + k0 + 8 * c) = o; }
    LDS_WAIT(); asm volatile("" ::: "memory");
}

#define XB_TMO      128
#define XB_XCNT(j)  (256  + 64 * (j))
#define XB_XSUB(j)  (1280 + 64 * (j))
#define XB_XGEN(j)  (2304 + 64 * (j))
#define XB_TOP      3328
#define XB_TOPGEN   3392
#define XCD_BAR_WORDS 3456
#define XB_SPIN_CAP (1u << 18)

__device__ __forceinline__ unsigned xb_ld(unsigned* p)              { return __hip_atomic_load(p, __ATOMIC_RELAXED, __HIP_MEMORY_SCOPE_AGENT); }
__device__ __forceinline__ unsigned xb_add(unsigned* p, unsigned v) { return __hip_atomic_fetch_add(p, v, __ATOMIC_RELAXED, __HIP_MEMORY_SCOPE_AGENT); }
__device__ __forceinline__ unsigned xb_xcc_id() { return (unsigned)__builtin_amdgcn_s_getreg((3 << 11) | 20) & 0xFu; }
#define XB_SPIN(cond, bar) do { unsigned _sp = 0; while (cond) { __builtin_amdgcn_s_sleep(1); \
    if ((++_sp & 255u) == 0u) { if (xb_ld(&(bar)[XB_TMO])) break; if (_sp > XB_SPIN_CAP) { atomicAdd(&(bar)[XB_TMO], 1u); break; } } } } while (0)

struct XcdBarrier {
    unsigned* bar; unsigned x;
    volatile LAS unsigned* st;
};

__device__ __forceinline__ XcdBarrier xcd_barrier_post(unsigned* bar, volatile LAS unsigned* st) {
    XcdBarrier b; b.bar = bar; b.x = xb_xcc_id(); b.st = st;
    if (threadIdx.x == 0) (void)xb_add(&bar[XB_XCNT(b.x)], 1u);
    return b;
}
__device__ __forceinline__ void xcd_barrier_complete(unsigned* bar, unsigned x, unsigned& nloc, unsigned& nx) {
    const unsigned G = gridDim.x * gridDim.y * gridDim.z;
    unsigned sum, cnt, mine, sp = 0u;
    for (;;) {
        sum = 0u; cnt = 0u; mine = 0u;
#pragma unroll
        for (unsigned j = 0; j < 16; ++j) { const unsigned c = xb_ld(&bar[XB_XCNT(j)]); sum += c; cnt += (c > 0u) ? 1u : 0u; mine = (j == x) ? c : mine; }
        if (sum == G) break;
        __builtin_amdgcn_s_sleep(1);
        if ((++sp & 255u) == 0u) { if (xb_ld(&bar[XB_TMO])) break; if (sp > XB_SPIN_CAP) { atomicAdd(&bar[XB_TMO], 1u); break; } }
    }
    nloc = mine > 0u ? mine : 1u; nx = cnt > 0u ? cnt : 1u;
}

__device__ __forceinline__ void xcd_barrier(const XcdBarrier& b) {
    asm volatile("s_waitcnt vmcnt(0)" ::: "memory");
    __syncthreads();
    if (threadIdx.x == 0) {
        unsigned* bar = b.bar;
        __builtin_amdgcn_s_waitcnt(0);
        unsigned nloc = b.st[0], nx = b.st[1];
        if (nloc == 0u) { xcd_barrier_complete(bar, b.x, nloc, nx); b.st[0] = nloc; b.st[1] = nx; }
        const unsigned old = xb_add(&bar[XB_XSUB(b.x)], 1u);
        const unsigned gen = old / nloc;
        if (old + 1u == (gen + 1u) * nloc) {
            __builtin_amdgcn_fence(__ATOMIC_RELEASE, "agent");
            asm volatile("s_waitcnt vmcnt(0)" ::: "memory");
            const unsigned og = xb_add(&bar[XB_TOP], 1u);
            const unsigned tg = og / nx;
            if (og + 1u == (tg + 1u) * nx) xb_add(&bar[XB_TOPGEN], 1u);
            else XB_SPIN(xb_ld(&bar[XB_TOPGEN]) == tg, bar);
            __builtin_amdgcn_fence(__ATOMIC_ACQUIRE, "agent");
            xb_add(&bar[XB_XGEN(b.x)], 1u);
            asm volatile("s_waitcnt vmcnt(0)" ::: "memory");
        } else {
            XB_SPIN(xb_ld(&bar[XB_XGEN(b.x)]) == gen, bar);
            __builtin_amdgcn_fence(__ATOMIC_ACQUIRE, "agent");
            asm volatile("s_waitcnt vmcnt(0)" ::: "memory");
        }
    }
    __syncthreads();
}

struct Args { const float* in[28]; float* out; unsigned char* ws; int ph_lo, ph_hi; };

__device__ __forceinline__ void p0_prologue(const Args& a, LAS unsigned char* lds, int wave, int lane) {
    unsigned char* ws = a.ws;
    LAS float* scr = (LAS float*)(lds + wave * 16384);
    const int gw = blockIdx.x * NWAVES + wave, NGW = gridDim.x * NWAVES;
    constexpr int I_UP = (D / 64) * (FF / 32), I_DN = (FF / 64) * (D / 32), I_IN = (D / 64) * (DIN / 32), I_OUT = (D / 64) * (D / 32), I_L64 = RW / 32, I_L128 = 2 * (RW / 32);
    constexpr int NITEMS = 4 * I_UP + 2 * I_DN + I_IN + I_OUT + 2 * I_L64 + I_L128;
#define P0_DECODE(it_, ti) do { int r = (it_); \
        if (r < I_UP) { ti = TItem{a.in[2], (bf16*)(ws + WS_W13_1), a.in[1], D, FF, 1, r}; break; } r -= I_UP; \
        if (r < I_UP) { ti = TItem{a.in[3], (bf16*)(ws + WS_W13_1), a.in[1], D, FF, 2, r}; break; } r -= I_UP; \
        if (r < I_DN) { ti = TItem{a.in[4], (bf16*)(ws + WS_W2_1), nullptr, FF, D, 0, r}; break; } r -= I_DN; \
        if (r < I_UP) { ti = TItem{a.in[24], (bf16*)(ws + WS_W13_2), a.in[23], D, FF, 1, r}; break; } r -= I_UP; \
        if (r < I_UP) { ti = TItem{a.in[25], (bf16*)(ws + WS_W13_2), a.in[23], D, FF, 2, r}; break; } r -= I_UP; \
        if (r < I_DN) { ti = TItem{a.in[26], (bf16*)(ws + WS_W2_2), nullptr, FF, D, 0, r}; break; } r -= I_DN; \
        if (r < I_IN) { ti = TItem{a.in[6], (bf16*)(ws + WS_WIN), a.in[5], D, DIN, 0, r}; break; } r -= I_IN; \
        if (r < I_OUT) { ti = TItem{a.in[22], (bf16*)(ws + WS_WOUT), nullptr, D, D, 0, r}; break; } r -= I_OUT; \
        if (r < I_L64) { ti = TItem{a.in[9], (bf16*)(ws + WS_WUPT), nullptr, 64, RW, 0, r}; break; } r -= I_L64; \
        if (r < I_L64) { ti = TItem{a.in[11], (bf16*)(ws + WS_AUPT), nullptr, 64, RW, 0, r}; break; } r -= I_L64; \
        ti = TItem{a.in[12], (bf16*)(ws + WS_GUPT), nullptr, 128, RW, 0, r}; } while (0)
    if (gw < NITEMS) { TItem cur; float v[32]; P0_DECODE(gw, cur); titem_load(cur, v, lane);
        for (int it = gw; it < NITEMS; it += NGW) {
            const bool has = it + NGW < NITEMS; TItem nx = cur; float v2[32];
            if (has) { P0_DECODE(it + NGW, nx); titem_load(nx, v2, lane); }
            titem_store(cur, v, scr, lane);
            if (has) { cur = nx;
#pragma unroll
                for (int i = 0; i < 32; ++i) v[i] = v2[i]; }
        } }
#undef P0_DECODE
    { const float* sw = a.in[20]; bf16* wc = (bf16*)(ws + WS_WC);
      for (int i = blockIdx.x * NTHREADS + wave * 64 + lane; i < 8 * 128 * 128 / 2; i += gridDim.x * NTHREADS) {
          const int e = 2 * i, s = e & 127, t = (e >> 7) & 127;
          const float v0 = (s <= t) ? sw[e] : 0.f, v1 = (s + 1 <= t) ? sw[e + 1] : 0.f;
          ((unsigned*)wc)[i] = pk(v0, v1); } }
    { const float* x = a.in[0]; bf16* xb = (bf16*)(ws + WS_WD); float* ss = (float*)(ws + WS_SS);
      f32x4 v[4];
#define X_LOAD(mm) do { const f32x4* xr_ = (const f32x4*)(x + (size_t)(mm) * D) + lane; _Pragma("unroll") for (int j = 0; j < 4; ++j) v[j] = __builtin_nontemporal_load(xr_ + 64 * j); } while (0)
      if (gw < M) X_LOAD(gw);
      for (int m = gw; m < M; m += NGW) {
          v2u* o8 = (v2u*)(xb + (size_t)m * D) + lane; float s = 0.f; v2u o[4];
#pragma unroll
          for (int j = 0; j < 4; ++j) { s += (v[j].x * v[j].x + v[j].y * v[j].y) + (v[j].z * v[j].z + v[j].w * v[j].w); o[j].x = pk(v[j].x, v[j].y); o[j].y = pk(v[j].z, v[j].w); }
          { const int mn = m + NGW < M ? m + NGW : m; X_LOAD(mn); }
#pragma unroll
          for (int j = 0; j < 4; ++j) o8[64 * j] = o[j];
          s = wave_sum(s);
          if (lane == 0) { ss[m] = s; ss[M + m] = 0.f; ss[2 * M + m] = 0.f; ss[3 * M + m] = 0.f; }
      }
#undef X_LOAD
      }
}

__device__ __forceinline__ f32x4 ld_bf4(const bf16* p) { const v2u u = *(const v2u*)p; return (f32x4){bf_lo(u.x), bf_hi(u.x), bf_lo(u.y), bf_hi(u.y)}; }
__device__ __forceinline__ f32x4 un_bf4(v2u u) { return (f32x4){bf_lo(u.x), bf_hi(u.x), bf_lo(u.y), bf_hi(u.y)}; }
__device__ __forceinline__ float gelu_as(float v) {
    const float t = __builtin_amdgcn_rcpf(fabsf(v) * 0.2316418882f + 1.0f);
    float q = t * 0.5307027145f + (-0.7265760135f); q = q * t + 0.7107068705f; q = q * t + (-0.142248368f); q = q * t + 0.127414796f; q = q * t;
    const float m = v * (q * __builtin_amdgcn_exp2f(v * v * (-0.72134752044f)));
    return v < 0.f ? m : v - m;
}
struct PV { v2u rc, rp, kc, kp; f32x4 rk; };
__device__ __forceinline__ void mp_load_pv(PV (&pv)[4], const bf16* P, const float* rkp, int t0, bool seq_start, int tb, int h, int fr, int fq) {
    const int tr = 16 * tb + fr; const bf16* pc = P + (size_t)(t0 + tr) * DIN + 64 * h + 4 * fq; const bf16* pp = (tr == 0 && seq_start) ? pc : pc - DIN;
#pragma unroll
    for (int nb = 0; nb < 4; ++nb) { pv[nb].rc = *(const v2u*)(pc + 16 * nb); pv[nb].kc = *(const v2u*)(pc + 512 + 16 * nb);
        pv[nb].rp = *(const v2u*)(pp + 16 * nb); pv[nb].kp = *(const v2u*)(pp + 512 + 16 * nb); pv[nb].rk = *(const f32x4*)(rkp + 64 * h + 16 * nb + 4 * fq); }
}
__device__ __forceinline__ void mp_a1_pre(const PV (&pv)[4], const LAS float* par, int t0, bool seq_start, int tb, int h, int fr, int fq, bf16* R, v2u (&kraw)[4], v2u (&rvp)[4], f32x4 (&rkv)[4], float& inv) {
    const int tr = 16 * tb + fr; const size_t t = (size_t)(t0 + tr); const float keep = (tr == 0 && seq_start) ? 0.f : 1.f;
    float ssq = 0.f;
#pragma unroll
    for (int nb = 0; nb < 4; ++nb) { const int cl = 16 * nb + 4 * fq;
        const f32x4 kc = un_bf4(pv[nb].kc), kp = un_bf4(pv[nb].kp) * keep, rc = un_bf4(pv[nb].rc), rp = un_bf4(pv[nb].rp) * keep;
        const f32x4 kv = kc + (kp - kc) * *(const LAS f32x4*)(par + 64 + cl); kraw[nb].x = pk(kv.x, kv.y); kraw[nb].y = pk(kv.z, kv.w);
        const f32x4 kk = kv * *(const LAS f32x4*)(par + 320 + cl); ssq += (kk.x * kk.x + kk.y * kk.y) + (kk.z * kk.z + kk.w * kk.w);
        const f32x4 rv = rc + (rp - rc) * *(const LAS f32x4*)(par + cl);
        v2u r2; r2.x = pk(rv.x, rv.y); r2.y = pk(rv.z, rv.w); *(v2u*)(R + t * RW + 64 * h + cl) = r2; rvp[nb] = r2; rkv[nb] = pv[nb].rk; }
    ssq = pg8::sum_xor32(pg8::sum_xor16(ssq));
    inv = 1.0f / fmaxf(sqrtf(ssq), 1e-12f);
}
struct A1Pend { v4u ab; f32x4 dec; v2u k2, g; size_t o, og; };
__device__ __forceinline__ void mp_a1_flush(const A1Pend& pe, bf16* K2, unsigned* AB, float* WD, bf16* YC) {
    *(v2u*)(K2 + pe.o) = pe.k2; *(v4u*)(AB + pe.o) = pe.ab; *(f32x4*)(WD + pe.o) = pe.dec; *(v2u*)(YC + pe.og) = pe.g;
}
__device__ __forceinline__ void mp_a1_main(const v2u (&kraw)[4], const v2u (&rvp)[4], const f32x4 (&rkv)[4], float* BON, float inv, const LAS bf16* Alow, const LAS float* par, const LAS bf16* wl, int t0, int tb, int h, int fr, int fq,
                                           bf16* K2, unsigned* AB, bf16* WD, bf16* YC) {
    constexpr int AL = 264;
    const LAS bf16* xrow = Alow + (16 * tb + fr) * AL + fq * 8;
    const size_t t = (size_t)(t0 + 16 * tb + fr);
    v2u sk[4], sg[4], sdec[4]; v4u sab[4]; float bon = 0.f;
#pragma unroll
    for (int nb = 0; nb < 4; ++nb) {
        const int nrow = 16 * nb + fr;
        bf16x8 fw[2], fa[2], fg[4];
#pragma unroll
        for (int ks = 0; ks < 2; ++ks) { fw[ks] = *(const LAS bf16x8*)(wl + nrow * 72 + ks * 32 + fq * 8); fa[ks] = *(const LAS bf16x8*)(wl + 4608 + nrow * 72 + ks * 32 + fq * 8); }
#pragma unroll
        for (int ks = 0; ks < 4; ++ks) fg[ks] = *(const LAS bf16x8*)(wl + 9216 + nrow * 136 + ks * 32 + fq * 8);
        f32x4 cw = (f32x4){0.f, 0.f, 0.f, 0.f}, ca = cw, cgv = cw;
#pragma unroll
        for (int ks = 0; ks < 2; ++ks) {
            cw = __builtin_amdgcn_mfma_f32_16x16x32_bf16(fw[ks], *(const LAS bf16x8*)(xrow + ks * 32), cw, 0, 0, 0);
            ca = __builtin_amdgcn_mfma_f32_16x16x32_bf16(fa[ks], *(const LAS bf16x8*)(xrow + 64 + ks * 32), ca, 0, 0, 0); }
#pragma unroll
        for (int ks = 0; ks < 4; ++ks)
            cgv = __builtin_amdgcn_mfma_f32_16x16x32_bf16(fg[ks], *(const LAS bf16x8*)(xrow + 128 + ks * 32), cgv, 0, 0, 0);
        const int cl = 16 * nb + 4 * fq, c = 64 * h + cl;
        const f32x4 wl = cw + *(const LAS f32x4*)(par + 192 + cl), al = ca + *(const LAS f32x4*)(par + 256 + cl);
        const f32x4 kkc = *(const LAS f32x4*)(par + 320 + cl), kac = *(const LAS f32x4*)(par + 384 + cl);
        const f32x4 kr = un_bf4(kraw[nb]), rq = un_bf4(rvp[nb]); f32x4 kn4, dec; v4u ab4;
#pragma unroll
        for (int j = 0; j < 4; ++j) {
            dec[j] = -0.60653065971263342f * sigmoidf(wl[j]);
            const float alpha = sigmoidf(al[j]);
            const float kkn = kr[j] * kkc[j] * inv;
            kn4[j] = kr[j] * (1.0f + (alpha - 1.0f) * kac[j]);
            bon = fmaf(rq[j] * kn4[j], rkv[nb][j], bon);
            ab4[j] = pk(-kkn, kkn * alpha); }
        sk[nb].x = pk(kn4.x, kn4.y); sk[nb].y = pk(kn4.z, kn4.w); sab[nb] = ab4; sdec[nb].x = pk(dec.x, dec.y); sdec[nb].y = pk(dec.z, dec.w); sg[nb].x = pk(cgv.x, cgv.y); sg[nb].y = pk(cgv.z, cgv.w); }
    const size_t o0 = t * RW + 64 * h + 4 * fq;
#pragma unroll
    for (int nb = 0; nb < 4; ++nb) *(v2u*)(K2 + o0 + 16 * nb) = sk[nb];
#pragma unroll
    for (int nb = 0; nb < 4; ++nb) *(v4u*)(AB + o0 + 16 * nb) = sab[nb];
#pragma unroll
    for (int nb = 0; nb < 4; ++nb) *(v2u*)(WD + o0 + 16 * nb) = sdec[nb];
#pragma unroll
    for (int nb = 0; nb < 4; ++nb) *(v2u*)(YC + t * D + 64 * h + 4 * fq + 16 * nb) = sg[nb];
    bon = pg8::sum_xor32(pg8::sum_xor16(bon)); if (fq == 0) BON[t * 8 + h] = bon;
}
struct B1L { bf16x8 bfr[4]; v2u pu[4]; float bias; };
__device__ __forceinline__ void mp_load_b1(B1L& L, const bf16* P, const bf16* Wc, const float* sb, int t0, int tb, int g, int fr, int fq) {
    const int nks = (tb >> 1) + 1, tr = 16 * tb + fr;
#pragma unroll
    for (int ks = 0; ks < 4; ++ks) if (ks < nks) L.bfr[ks] = *(const bf16x8*)(Wc + (size_t)(g * 128 + tr) * 128 + ks * 32 + fq * 8);
#pragma unroll
    for (int cb = 0; cb < 4; ++cb) L.pu[cb] = *(const v2u*)(P + (size_t)(t0 + tr) * DIN + 1792 + 64 * g + 16 * cb + 4 * fq);
    L.bias = sb[g * 128 + tr];
}
__device__ __forceinline__ void mp_b1_body(const B1L& L, const LAS bf16* Vt, bf16* YC, int t0, int tb, int g, int fr, int fq) {
    constexpr int VP = 136; const int nks = (tb >> 1) + 1; const size_t t = (size_t)(t0 + 16 * tb + fr);
#pragma unroll
    for (int cb = 0; cb < 4; ++cb) { f32x4 acc = (f32x4){0.f, 0.f, 0.f, 0.f};
#pragma unroll
        for (int ks = 0; ks < 4; ++ks) if (ks < nks)
            acc = __builtin_amdgcn_mfma_f32_16x16x32_bf16(*(const LAS bf16x8*)(Vt + ((fr & 7) * 65 + 8 * g + 2 * cb + (fr >> 3)) * VP + ks * 32 + fq * 8), L.bfr[ks], acc, 0, 0, 0);
        const int c = 64 * g + 16 * cb + 4 * fq; const f32x4 pu = un_bf4(L.pu[cb]);
        v2u o; o.x = pk(gelu_as(pu.x) * (acc.x + L.bias), gelu_as(pu.y) * (acc.y + L.bias)); o.y = pk(gelu_as(pu.z) * (acc.z + L.bias), gelu_as(pu.w) * (acc.w + L.bias));
        *(v2u*)(YC + t * D + 512 + c) = o; }
}
__device__ __forceinline__ void mp_stage_load(v4u (&wst)[4], const bf16* wupT, const bf16* aupT, const bf16* gupT, int h, int tid) {
    const unsigned off = (unsigned)tid * 16u;
    wst[0] = *(const v4u*)((const char*)(wupT + (size_t)h * 4096) + off);
    wst[1] = *(const v4u*)((const char*)(aupT + (size_t)h * 4096) + off);
    wst[2] = *(const v4u*)((const char*)(gupT + (size_t)h * 8192) + off);
    wst[3] = *(const v4u*)((const char*)(gupT + (size_t)h * 8192) + 8192 + off);
}
__device__ __forceinline__ void mp_stage_store(const v4u (&wst)[4], LAS bf16* wl, int tid) {
    *(LAS v4u*)(wl + (tid >> 3) * 72 + (tid & 7) * 8) = wst[0];
    *(LAS v4u*)(wl + 4608 + (tid >> 3) * 72 + (tid & 7) * 8) = wst[1];
    *(LAS v4u*)(wl + 9216 + (tid >> 4) * 136 + (tid & 15) * 8) = wst[2];
    *(LAS v4u*)(wl + 9216 + (32 + (tid >> 4)) * 136 + (tid & 15) * 8) = wst[3];
}
__device__ __forceinline__ void mixer_prep(const Args& a, LAS unsigned char* lds, int wave, int lane) {
    unsigned char* ws = a.ws;
    const bf16* P = (const bf16*)(ws + WS_P);
    const float* mu = a.in[7];
    const bf16* wupT = (const bf16*)(ws + WS_WUPT); const bf16* aupT = (const bf16*)(ws + WS_AUPT); const bf16* gupT = (const bf16*)(ws + WS_GUPT); const bf16* Wc = (const bf16*)(ws + WS_WC);
    bf16* RB = (bf16*)(ws + WS_RK); bf16* K2 = (bf16*)(ws + WS_RK + 32 * MiB); unsigned* AB = (unsigned*)(ws + WS_AB); bf16* WD = (bf16*)(ws + WS_WD); bf16* V = (bf16*)(ws + WS_V); bf16* YC = (bf16*)(ws + WS_YCAT);
    constexpr int AL = 264;
    constexpr int VP = 136;
    LAS bf16* Alow = (LAS bf16*)lds;
    LAS bf16* Vt = (LAS bf16*)lds;
    LAS float* par = (LAS float*)(lds + 128 * AL * 2) + wave * 448;
    const int lane_in = lane;
    for (int unit = blockIdx.x; unit < M / 128; unit += gridDim.x) {
        int oz = 0; asm volatile("" : "+v"(oz));
        const int lane = lane_in + oz, tid = wave * 64 + lane, fr = lane & 15, fq = lane >> 4;
        const int t0 = unit * 128; const bool seq_start = (t0 % SEQ) == 0;
        { const int c = 64 * wave + lane;
          par[lane] = mu[c]; par[64 + lane] = mu[512 + c]; par[128 + lane] = mu[1024 + c]; par[192 + lane] = a.in[8][c]; par[256 + lane] = a.in[10][c]; par[320 + lane] = a.in[13][c]; par[384 + lane] = a.in[14][c]; }
        { v4u wst[4]; mp_stage_load(wst, wupT, aupT, gupT, 0, tid); mp_stage_store(wst, (LAS bf16*)(lds + 81920), tid); }
        { const int cg8 = tid & 31, col = 1536 + 8 * cg8;
          const f32x4 m0 = *(const f32x4*)(mu + col), m1 = *(const f32x4*)(mu + col + 4);
          const float mm[8] = {m0.x, m0.y, m0.z, m0.w, m1.x, m1.y, m1.z, m1.w};
          v4u cu[8], pu[8];
#pragma unroll
          for (int pass = 0; pass < 8; ++pass) { const int row = pass * 16 + (tid >> 5); const size_t off = (size_t)(t0 + row) * DIN + col;
              cu[pass] = *(const v4u*)(P + off); pu[pass] = *(const v4u*)(P + ((row == 0 && seq_start) ? off : off - DIN)); }
#pragma unroll
          for (int pass = 0; pass < 8; ++pass) { const int row = pass * 16 + (tid >> 5); const float keep = (row == 0 && seq_start) ? 0.f : 1.f;
              const unsigned cw[4] = {cu[pass].x, cu[pass].y, cu[pass].z, cu[pass].w}, pw[4] = {pu[pass].x, pu[pass].y, pu[pass].z, pu[pass].w}; float c[8];
#pragma unroll
              for (int i = 0; i < 8; ++i) { const float cv = (i & 1) ? bf_hi(cw[i >> 1]) : bf_lo(cw[i >> 1]), qv = ((i & 1) ? bf_hi(pw[i >> 1]) : bf_lo(pw[i >> 1])) * keep;
                  float v = cv + (qv - cv) * mm[i];
                  if (cg8 < 8) v = 1.0f - 2.0f * __builtin_amdgcn_rcpf(__expf(2.0f * v) + 1.0f); else if (cg8 >= 16) v = sigmoidf(v);
                  c[i] = v; }
              v4u o; o.x = pk(c[0], c[1]); o.y = pk(c[2], c[3]); o.z = pk(c[4], c[5]); o.w = pk(c[6], c[7]);
              *(LAS v4u*)(Alow + row * AL + 8 * cg8) = o; } }
        { const int cg8 = tid & 63, col = 1024 + 8 * cg8;
          const f32x4 m0 = *(const f32x4*)(mu + col), m1 = *(const f32x4*)(mu + col + 4);
          const float mm[8] = {m0.x, m0.y, m0.z, m0.w, m1.x, m1.y, m1.z, m1.w};
#pragma unroll
          for (int half = 0; half < 2; ++half) { v4u cu[8], pu[8];
#pragma unroll
              for (int pass = 0; pass < 8; ++pass) { const int row = (half * 8 + pass) * 8 + (tid >> 6); const size_t off = (size_t)(t0 + row) * DIN + col;
                  cu[pass] = *(const v4u*)(P + off); pu[pass] = *(const v4u*)(P + ((row == 0 && seq_start) ? off : off - DIN)); }
#pragma unroll
              for (int pass = 0; pass < 8; ++pass) { const int row = (half * 8 + pass) * 8 + (tid >> 6); const float keep = (row == 0 && seq_start) ? 0.f : 1.f;
                  const unsigned cw[4] = {cu[pass].x, cu[pass].y, cu[pass].z, cu[pass].w}, pw[4] = {pu[pass].x, pu[pass].y, pu[pass].z, pu[pass].w}; float c[8];
#pragma unroll
                  for (int i = 0; i < 8; ++i) { const float cv = (i & 1) ? bf_hi(cw[i >> 1]) : bf_lo(cw[i >> 1]), qv = ((i & 1) ? bf_hi(pw[i >> 1]) : bf_lo(pw[i >> 1])) * keep; c[i] = cv + (qv - cv) * mm[i]; }
                  v4u o; o.x = pk(c[0], c[1]); o.y = pk(c[2], c[3]); o.z = pk(c[4], c[5]); o.w = pk(c[6], c[7]);
                  *(v4u*)(V + (size_t)(t0 + row) * RW + 8 * cg8) = o; } } }
        __syncthreads();
        { const int tb = wave; PV pv[4]; v2u kraw[4]; float inv; v2u rvp[4]; f32x4 rkv[4]; float* BON = a.out + 16 * 1048576;
          const LAS float* par0 = (const LAS float*)(lds + 128 * AL * 2);
          LAS bf16* wbuf = (LAS bf16*)(lds + 81920);
          mp_load_pv(pv, P, a.in[15], t0, seq_start, tb, 0, fr, fq);
          for (int h = 0; h < 8; ++h) {
              v4u wst[4]; const int hn = h + 1 < 8 ? h + 1 : 7;
              mp_stage_load(wst, wupT, aupT, gupT, hn, tid);
              mp_a1_pre(pv, par0 + h * 448, t0, seq_start, tb, h, fr, fq, RB, kraw, rvp, rkv, inv);
              mp_load_pv(pv, P, a.in[15], t0, seq_start, tb, hn, fr, fq);
              mp_a1_main(kraw, rvp, rkv, BON, inv, Alow, par0 + h * 448, wbuf + (h & 1) * 17920, t0, tb, h, fr, fq, K2, AB, WD, YC);
              mp_stage_store(wst, wbuf + ((h + 1) & 1) * 17920, tid);
              asm volatile("s_waitcnt lgkmcnt(0)" ::: "memory"); __builtin_amdgcn_s_barrier(); asm volatile("" ::: "memory");
          } }
        __syncthreads();
        { f32x4 lg0 = *(const f32x4*)(a.in[18] + 8 * lane), lg1 = *(const f32x4*)(a.in[18] + 8 * lane + 4), lb0 = *(const f32x4*)(a.in[19] + 8 * lane), lb1 = *(const f32x4*)(a.in[19] + 8 * lane + 4);
          const float lg[8] = {lg0.x, lg0.y, lg0.z, lg0.w, lg1.x, lg1.y, lg1.z, lg1.w}, lb[8] = {lb0.x, lb0.y, lb0.z, lb0.w, lb1.x, lb1.y, lb1.z, lb1.w};
#pragma unroll 1
          for (int half = 0; half < 2; ++half) {
          v4u pvv[8];
#pragma unroll
          for (int i = 0; i < 8; ++i) pvv[i] = *(const v4u*)(P + (size_t)(t0 + 16 * wave + 8 * half + i) * DIN + 2304 + 8 * lane);
#pragma unroll
          for (int i = 0; i < 8; ++i) { const int s = 16 * wave + 8 * half + i; const v4u u = pvv[i];
              float x[8] = {bf_lo(u.x), bf_hi(u.x), bf_lo(u.y), bf_hi(u.y), bf_lo(u.z), bf_hi(u.z), bf_lo(u.w), bf_hi(u.w)}; float sm = 0.f;
#pragma unroll
              for (int j = 0; j < 8; ++j) { x[j] = gelu_as(x[j]); sm += x[j]; }
              const float mean = wave_sum(sm) * (1.0f / 512.0f); float sq = 0.f;
#pragma unroll
              for (int j = 0; j < 8; ++j) { x[j] -= mean; sq += x[j] * x[j]; }
              const float rs = __builtin_amdgcn_rsqf(wave_sum(sq) * (1.0f / 512.0f) + LN_EPS);
#pragma unroll
              for (int j = 0; j < 8; j += 2) { const unsigned w2 = pk(x[j] * rs * lg[j] + lb[j], x[j + 1] * rs * lg[j + 1] + lb[j + 1]);
                  Vt[(j * 65 + lane) * VP + s] = (bf16)(w2 & 0xffffu); Vt[((j + 1) * 65 + lane) * VP + s] = (bf16)(w2 >> 16); }
          } } }
        __syncthreads();
        { const int g = wave; const float* sb = a.in[21]; B1L LA, LB;
          mp_load_b1(LA, P, Wc, sb, t0, 0, g, fr, fq);
#pragma unroll
          for (int tb = 0; tb < 8; tb += 2) {
              mp_load_b1(LB, P, Wc, sb, t0, tb + 1, g, fr, fq);
              mp_b1_body(LA, Vt, YC, t0, tb, g, fr, fq);
              if (tb + 2 < 8) mp_load_b1(LA, P, Wc, sb, t0, tb + 2, g, fr, fq);
              mp_b1_body(LB, Vt, YC, t0, tb + 1, g, fr, fq);
          } }
        __syncthreads();
    }
}

__device__ __forceinline__ bf16 to_bf16(float x) { return (bf16)(pk(x, 0.f) & 0xffffu); }
__device__ __forceinline__ void chunk_prep(const Args& a, LAS unsigned char* lds, int wave, int lane) {
    unsigned char* ws = a.ws;
    const bf16* RB = (const bf16*)(ws + WS_RK); const bf16* K2 = (const bf16*)(ws + WS_RK + 32 * MiB); const unsigned* AB = (const unsigned*)(ws + WS_AB); const bf16* LW = (const bf16*)(ws + WS_WD); const bf16* V = (const bf16*)(ws + WS_V);
    unsigned char* OPS = ws + WS_P; float* GAM = (float*)(ws + WS_GAM);
    LAS unsigned char* L = lds + wave * 16384;
    LAS bf16* tA = (LAS bf16*)L; LAS bf16* tB = tA + 16 * 72; LAS bf16* tK = tB + 16 * 72; LAS bf16* tR = tK + 16 * 72;
    LAS float* coef = (LAS float*)(L + 9216);
    LAS bf16* stage = (LAS bf16*)(L + 13312);
    LAS bf16* nm = (LAS bf16*)(L + 15360);
    const int fr = lane & 15, fq = lane >> 4;
    const int gw = blockIdx.x * NWAVES + wave, NGW = gridDim.x * NWAVES;
    const int j5 = lane & 31, pos = (lane & 32) + ((j5 >> 2) & 3) * 8 + (((j5 >> 4) << 2) | (j5 & 3));
    unsigned short rr[16], kk[16], vv[16], lw[16]; unsigned ab[16];
#define CP_LOAD(task_) do { const int h_ = (task_) & 7, c_ = ((task_) >> 3) & 255, bq_ = (task_) >> 11; const size_t b_ = ((size_t)bq_ * SEQ + c_ * 16) * RW + h_ * 64 + lane; \
        _Pragma("unroll") for (int t = 0; t < 16; ++t) { rr[t] = __builtin_nontemporal_load(RB + b_ + (size_t)t * RW); kk[t] = __builtin_nontemporal_load(K2 + b_ + (size_t)t * RW); ab[t] = __builtin_nontemporal_load(AB + b_ + (size_t)t * RW); lw[t] = __builtin_nontemporal_load(LW + b_ + (size_t)t * RW); vv[t] = V[b_ + (size_t)t * RW]; }     } while (0)
    if (gw < 16384) CP_LOAD(gw);
    for (int task = gw; task < 16384; task += NGW) {
        const int slot = ((((task >> 11) << 3) | (task & 7)) << 8) | ((task >> 3) & 255);
        unsigned char* op = OPS + (size_t)slot * OPS_BYTES;
        v4u bk[4]; v2u vq[4]; float E = 1.f;
        { float cum = 0.f;
#pragma unroll
          for (int q = 0; q < 4; ++q) { float Bq[4], Kq[4];
#pragma unroll
              for (int e = 0; e < 4; ++e) { const int t = 4 * q + e;
                  const float af = bf_lo(ab[t]), bfv = bf_hi(ab[t]), rf = __uint_as_float((unsigned)rr[t] << 16), kf = __uint_as_float((unsigned)kk[t] << 16);
                  const float At = af * E; cum += __uint_as_float((unsigned)lw[t] << 16); E = __expf(cum); const float Ei = __builtin_amdgcn_rcpf(E);
                  Bq[e] = bfv * Ei; Kq[e] = kf * Ei; const float Rt = rf * E;
                  tA[t * 72 + lane] = to_bf16(At); tR[t * 72 + lane] = to_bf16(Rt); }
              const v4u o = (v4u){pk(Bq[0], Bq[1]), pk(Bq[2], Bq[3]), pk(Kq[0], Kq[1]), pk(Kq[2], Kq[3])}; bk[q] = o;
#pragma unroll
              for (int e = 0; e < 4; ++e) { const unsigned w2 = (e < 2) ? (e == 0 ? o.x : o.x >> 16) : (e == 2 ? o.y : o.y >> 16); const unsigned k2 = (e < 2) ? (e == 0 ? o.z : o.z >> 16) : (e == 2 ? o.w : o.w >> 16);
                  tB[(4 * q + e) * 72 + lane] = (bf16)(w2 & 0xffffu); tK[(4 * q + e) * 72 + lane] = (bf16)(k2 & 0xffffu); }
              vq[q].x = (unsigned)vv[4 * q] | ((unsigned)vv[4 * q + 1] << 16); vq[q].y = (unsigned)vv[4 * q + 2] | ((unsigned)vv[4 * q + 3] << 16); } }
        asm volatile("" ::: "memory");
        { const int tn = task + NGW < 16384 ? task + NGW : task; CP_LOAD(tn); }
        asm volatile("" ::: "memory");
#pragma unroll
        for (int q = 0; q < 4; ++q) { *(v4u*)(op + OP_BK + lane * 64 + q * 16) = bk[q]; *(v2u*)(op + OP_V + (((lane >> 4) * 4 + q) * 16 + (lane & 15)) * 8) = vq[q]; }
        GAM[(size_t)slot * 64 + lane] = E;
        LDS_WAIT(); asm volatile("" ::: "memory");
        { f32x4 nab = (f32x4){0.f, 0.f, 0.f, 0.f}, nak = nab, mbr = nab, mkr = nab;
#pragma unroll
          for (int ks = 0; ks < 2; ++ks) { const int o = fr * 72 + ks * 32 + fq * 8;
              const bf16x8 fB = *(const LAS bf16x8*)(tB + o), fK = *(const LAS bf16x8*)(tK + o), gA = *(const LAS bf16x8*)(tA + o), gR = *(const LAS bf16x8*)(tR + o);
              nab = __builtin_amdgcn_mfma_f32_16x16x32_bf16(fB, gA, nab, 0, 0, 0); nak = __builtin_amdgcn_mfma_f32_16x16x32_bf16(fK, gA, nak, 0, 0, 0);
              mbr = __builtin_amdgcn_mfma_f32_16x16x32_bf16(fB, gR, mbr, 0, 0, 0); mkr = __builtin_amdgcn_mfma_f32_16x16x32_bf16(fK, gR, mkr, 0, 0, 0); }
#pragma unroll
          for (int jj = 0; jj < 4; ++jj) { const int tau = 4 * fq + jj;
              coef[0 * 256 + tau * 16 + fr] = tau < fr ? nab[jj] : 0.f; coef[1 * 256 + tau * 16 + fr] = tau < fr ? nak[jj] : 0.f;
              coef[2 * 256 + tau * 16 + fr] = tau <= fr ? mbr[jj] : 0.f; coef[3 * 256 + tau * 16 + fr] = tau <= fr ? mkr[jj] : 0.f; } }
        LDS_WAIT(); asm volatile("" ::: "memory");
        float Ap[16], Np[16];
#pragma unroll
        for (int t = 0; t < 16; ++t) { float acc = bf_lo((unsigned)tA[t * 72 + lane]), accn = coef[256 + fr * 16 + t];
#pragma unroll
            for (int tau = 0; tau < t; ++tau) { const float co = coef[tau * 16 + t]; acc = fmaf(co, Ap[tau], acc); accn = fmaf(co, Np[tau], accn); }
            Ap[t] = acc; Np[t] = accn; stage[t * 64 + pos] = to_bf16(acc);
            if (lane < 16) nm[t * 16 + lane] = to_bf16(accn); }
        LDS_WAIT(); asm volatile("" ::: "memory");
        { const v4u x0 = *(const LAS v4u*)((const LAS unsigned char*)stage + lane * 16), x1 = *(const LAS v4u*)((const LAS unsigned char*)stage + 1024 + lane * 16);
          *(v4u*)(op + OP_A + lane * 16) = x0; *(v4u*)(op + OP_A + 1024 + lane * 16) = x1; }
        LDS_WAIT(); asm volatile("" ::: "memory");
#pragma unroll
        for (int t = 0; t < 16; ++t) { float acc = bf_lo((unsigned)tR[t * 72 + lane]), accm = coef[768 + fr * 16 + t];
#pragma unroll
            for (int tau = 0; tau <= t; ++tau) { const float co = coef[512 + tau * 16 + t]; acc = fmaf(co, Ap[tau], acc); accm = fmaf(co, Np[tau], accm); }
            stage[t * 64 + pos] = to_bf16(acc);
            if (lane < 16) nm[256 + t * 16 + lane] = to_bf16(accm); }
        LDS_WAIT(); asm volatile("" ::: "memory");
        { const v4u x0 = *(const LAS v4u*)((const LAS unsigned char*)stage + lane * 16), x1 = *(const LAS v4u*)((const LAS unsigned char*)stage + 1024 + lane * 16);
          const v4u xn = *(const LAS v4u*)((const LAS unsigned char*)nm + lane * 16);
          *(v4u*)(op + OP_R + lane * 16) = x0; *(v4u*)(op + OP_R + 1024 + lane * 16) = x1; *(v4u*)(op + OP_N + lane * 16) = xn; }
        LDS_WAIT(); asm volatile("" ::: "memory");
    }
}

#undef CP_LOAD
struct ChunkOpsS { v4u a0, a1, bk0, bk1, bk2, bk3; v2u n, v; f32x4 g0, g1, g2, g3; };
struct ChunkOpsY { v4u r0, r1; v2u m, v; };
__device__ __forceinline__ void scan_phase(const Args& a, LAS unsigned char* lds, int wave, int lane) {
    unsigned char* ws = a.ws;
    volatile LAS int* ready = (volatile LAS int*)(lds + 16384); volatile LAS int* consumed = (volatile LAS int*)(lds + 16384 + 256);
    if (wave == 0 && lane == 0) { *ready = 0; *consumed = 0; }
    __syncthreads();
    if (wave < 2) {
        const int fr = lane & 15, fq = lane >> 4; int it = 0;
        for (int blk = blockIdx.x; blk < 256; blk += gridDim.x, ++it) {
            const int task = (gridDim.x == 256) ? (((blk & 7) * 8 + (blk >> 5)) * 4 + ((blk >> 3) & 3)) : blk;
            const int bh = task >> 2, sl = task & 3;
            const unsigned char* op0 = ws + WS_P + (size_t)bh * 256 * OPS_BYTES;
            const int offA = (fr * 64 + fq * 8) * 2, offBK = OP_BK + fr * 64 + fq * 16, offN = OP_N + (fr * 16 + 4 * fq) * 2, offM = OP_M + (fr * 16 + 4 * fq) * 2, offV = OP_V + ((sl * 4 + fq) * 16 + fr) * 8;
#define BX(x) __builtin_bit_cast(bf16x8, (x))
            if (wave == 0) {
                const float* gam0 = (const float*)(ws + WS_GAM) + (size_t)bh * 256 * 64 + 4 * fq;
                f32x4 S0 = (f32x4){0.f, 0.f, 0.f, 0.f}, S1 = S0, S2 = S0, S3 = S0;
                ChunkOpsS A, B;
#define CS_LOAD(X, cc) do { int c_ = (cc); c_ = c_ < 256 ? c_ : 255; const unsigned char* o_ = op0 + (size_t)c_ * OPS_BYTES; const float* g_ = gam0 + c_ * 64; \
                    X.a0 = *(const v4u*)(o_ + OP_A + offA); X.a1 = *(const v4u*)(o_ + OP_A + offA + 64); X.n = *(const v2u*)(o_ + offN); X.v = *(const v2u*)(o_ + offV); \
                    X.bk0 = *(const v4u*)(o_ + offBK); X.bk1 = *(const v4u*)(o_ + offBK + 1024); X.bk2 = *(const v4u*)(o_ + offBK + 2048); X.bk3 = *(const v4u*)(o_ + offBK + 3072); \
                    X.g0 = *(const f32x4*)(g_); X.g1 = *(const f32x4*)(g_ + 16); X.g2 = *(const f32x4*)(g_ + 32); X.g3 = *(const f32x4*)(g_ + 48); } while (0)
#define CS_COMP(X, cc) do { const int g_ = it * 256 + (cc); \
                    const v4u sb0 = (v4u){pk(S0[0], S0[1]), pk(S0[2], S0[3]), pk(S1[0], S1[1]), pk(S1[2], S1[3])}, sb1 = (v4u){pk(S2[0], S2[1]), pk(S2[2], S2[3]), pk(S3[0], S3[1]), pk(S3[2], S3[3])}; \
                    while (g_ - *consumed >= 4) __builtin_amdgcn_s_sleep(1); \
                    { LAS v4u* slot_ = (LAS v4u*)(lds + (g_ & 3) * 2048); slot_[lane] = sb0; slot_[64 + lane] = sb1; } \
                    asm volatile("s_waitcnt lgkmcnt(0)" ::: "memory"); if (lane == 0) *ready = g_ + 1; \
                    const v4u vb = (v4u){X.v.x, X.v.y, 0u, 0u}, nb = (v4u){X.n.x, X.n.y, 0u, 0u}; \
                    f32x4 U = __builtin_amdgcn_mfma_f32_16x16x32_bf16(BX(X.a0), BX(sb0), (f32x4){0.f, 0.f, 0.f, 0.f}, 0, 0, 0); \
                    U = __builtin_amdgcn_mfma_f32_16x16x32_bf16(BX(X.a1), BX(sb1), U, 0, 0, 0); U = __builtin_amdgcn_mfma_f32_16x16x32_bf16(BX(nb), BX(vb), U, 0, 0, 0); \
                    const v4u uv = (v4u){pk(U[0], U[1]), pk(U[2], U[3]), X.v.x, X.v.y}; \
                    S0 = __builtin_amdgcn_mfma_f32_16x16x32_bf16(BX(X.bk0), BX(uv), S0, 0, 0, 0) * X.g0; S1 = __builtin_amdgcn_mfma_f32_16x16x32_bf16(BX(X.bk1), BX(uv), S1, 0, 0, 0) * X.g1; \
                    S2 = __builtin_amdgcn_mfma_f32_16x16x32_bf16(BX(X.bk2), BX(uv), S2, 0, 0, 0) * X.g2; S3 = __builtin_amdgcn_mfma_f32_16x16x32_bf16(BX(X.bk3), BX(uv), S3, 0, 0, 0) * X.g3; } while (0)
                CS_LOAD(A, 0);
                for (int c = 0; c < 256; c += 2) { CS_LOAD(B, c + 1); CS_COMP(A, c); CS_LOAD(A, c + 2); CS_COMP(B, c + 1); }
#undef CS_LOAD
#undef CS_COMP
            } else {
                float* Y = (float*)(ws + WS_WD) + ((size_t)(bh >> 3) * SEQ + 4 * fq) * RW + (bh & 7) * 64 + 16 * sl + fr;
                ChunkOpsY A, B;
#define CY_LOAD(X, cc) do { int c_ = (cc); c_ = c_ < 256 ? c_ : 255; const unsigned char* o_ = op0 + (size_t)c_ * OPS_BYTES; \
                    X.r0 = *(const v4u*)(o_ + OP_R + offA); X.r1 = *(const v4u*)(o_ + OP_R + offA + 64); X.m = *(const v2u*)(o_ + offM); X.v = *(const v2u*)(o_ + offV); } while (0)
#define CY_COMP(X, cc) do { const int g_ = it * 256 + (cc); \
                    while (*ready < g_ + 1) __builtin_amdgcn_s_sleep(1); \
                    const LAS v4u* slot_ = (const LAS v4u*)(lds + (g_ & 3) * 2048); const v4u sb0 = slot_[lane], sb1 = slot_[64 + lane]; \
                    asm volatile("s_waitcnt lgkmcnt(0)" ::: "memory"); if (lane == 0) *consumed = g_ + 1; \
                    const v4u vb = (v4u){X.v.x, X.v.y, 0u, 0u}, mb = (v4u){X.m.x, X.m.y, 0u, 0u}; \
                    f32x4 Yv = __builtin_amdgcn_mfma_f32_16x16x32_bf16(BX(X.r0), BX(sb0), (f32x4){0.f, 0.f, 0.f, 0.f}, 0, 0, 0); \
                    Yv = __builtin_amdgcn_mfma_f32_16x16x32_bf16(BX(X.r1), BX(sb1), Yv, 0, 0, 0); Yv = __builtin_amdgcn_mfma_f32_16x16x32_bf16(BX(mb), BX(vb), Yv, 0, 0, 0); \
                    float* y_ = Y + (size_t)(cc) * 16 * RW; y_[0] = Yv[0]; y_[RW] = Yv[1]; y_[2 * RW] = Yv[2]; y_[3 * RW] = Yv[3]; } while (0)
                CY_LOAD(A, 0);
                for (int c = 0; c < 256; c += 2) { CY_LOAD(B, c + 1); CY_COMP(A, c); CY_LOAD(A, c + 2); CY_COMP(B, c + 1); }
#undef CY_LOAD
#undef CY_COMP
            }
#undef BX
        }
    }
}

__device__ __forceinline__ float grp8_sum(float v) { return pg8::sum_grp8(v); }
__device__ __forceinline__ void post_phase(const Args& a, int wave, int lane) {
    unsigned char* ws = a.ws;
    const float* Y = (const float*)(ws + WS_WD); const bf16* RB = (const bf16*)(ws + WS_RK); const bf16* K2 = (const bf16*)(ws + WS_RK + 32 * MiB); const bf16* V = (const bf16*)(ws + WS_V); bf16* YC = (bf16*)(ws + WS_YCAT);
    const int gw = blockIdx.x * NWAVES + wave, NGW = gridDim.x * NWAVES, c = 8 * lane;
    float gnw[8], gnb[8], rkc[8];
#pragma unroll
    for (int j = 0; j < 8; ++j) { gnw[j] = a.in[16][c + j]; gnb[j] = a.in[17][c + j]; rkc[j] = a.in[15][c + j]; }
    f32x4 y0, y1; v4u vu, gu; float bnl; const float* BON = a.out + 16 * 1048576;
#define POST_LOAD(tt) do { const size_t o_ = (size_t)(tt) * RW + c; y0 = __builtin_nontemporal_load((const f32x4*)(Y + o_)); y1 = __builtin_nontemporal_load((const f32x4*)(Y + o_ + 4)); bnl = BON[(size_t)(tt) * 8 + (lane >> 3)]; vu = *(const v4u*)(V + o_); gu = *(const v4u*)(YC + (size_t)(tt) * D + c); } while (0)
    if (gw < M) POST_LOAD(gw);
    for (int t = gw; t < M; t += NGW) {
        float yv[8] = {y0.x, y0.y, y0.z, y0.w, y1.x, y1.y, y1.z, y1.w};
        const float bn = bnl;
        const float vf[8] = {bf_lo(vu.x), bf_hi(vu.x), bf_lo(vu.y), bf_hi(vu.y), bf_lo(vu.z), bf_hi(vu.z), bf_lo(vu.w), bf_hi(vu.w)};
        const float gf[8] = {bf_lo(gu.x), bf_hi(gu.x), bf_lo(gu.y), bf_hi(gu.y), bf_lo(gu.z), bf_hi(gu.z), bf_lo(gu.w), bf_hi(gu.w)};
        { const int tn = t + NGW < M ? t + NGW : t; POST_LOAD(tn); }
        float sm = 0.f;
#pragma unroll
        for (int j = 0; j < 8; ++j) sm += yv[j];
        const float mean = grp8_sum(sm) * (1.0f / 64.0f); float sq = 0.f;
#pragma unroll
        for (int j = 0; j < 8; ++j) { yv[j] -= mean; sq += yv[j] * yv[j]; }
        const float rs = __builtin_amdgcn_rsqf(grp8_sum(sq) * (1.0f / 64.0f) + GN_EPS);
        float ov[8];
#pragma unroll
        for (int j = 0; j < 8; ++j) ov[j] = (yv[j] * rs * gnw[j] + gnb[j] + bn * vf[j]) * gf[j];
        v4u w; w.x = pk(ov[0], ov[1]); w.y = pk(ov[2], ov[3]); w.z = pk(ov[4], ov[5]); w.w = pk(ov[6], ov[7]);
        *(v4u*)(YC + (size_t)t * D + c) = w;
    }
#undef POST_LOAD
}

__device__ __forceinline__ void final_phase(const Args& a, int wave, int lane) {
    const float* ss = (const float*)(a.ws + WS_SS) + 3 * M; const float* fg = a.in[27]; const bf16* X3 = (const bf16*)(a.ws + WS_WD);
    const int gw = blockIdx.x * NWAVES + wave, NGW = gridDim.x * NWAVES;
    f32x4 g[4];
#pragma unroll
    for (int j = 0; j < 4; ++j) g[j] = *(const f32x4*)(fg + (j >> 1) * 512 + 8 * lane + (j & 1) * 4);
    v4u v[2]; float sv = 0.f;
#define FIN_LOAD(mm) do { const v4u* p_ = (const v4u*)(X3 + (size_t)(mm) * D) + lane; v[0] = __builtin_nontemporal_load(p_); v[1] = __builtin_nontemporal_load(p_ + 64); sv = ss[mm]; } while (0)
    if (gw < M) FIN_LOAD(gw);
    for (int m = gw; m < M; m += NGW) {
        const float rs = __builtin_amdgcn_rsqf(sv * (1.0f / 1024.0f) + RMS_EPS);
        f32x4 o4[4];
#pragma unroll
        for (int h = 0; h < 2; ++h) { o4[2 * h] = (f32x4){bf_lo(v[h].x), bf_hi(v[h].x), bf_lo(v[h].y), bf_hi(v[h].y)} * rs * g[2 * h]; o4[2 * h + 1] = (f32x4){bf_lo(v[h].z), bf_hi(v[h].z), bf_lo(v[h].w), bf_hi(v[h].w)} * rs * g[2 * h + 1]; }
        { const int mn = m + NGW < M ? m + NGW : m; FIN_LOAD(mn); }
        float* o = a.out + (size_t)m * D + 8 * lane;
        __builtin_nontemporal_store(o4[0], (f32x4*)(o)); __builtin_nontemporal_store(o4[1], (f32x4*)(o + 4)); __builtin_nontemporal_store(o4[2], (f32x4*)(o + 512)); __builtin_nontemporal_store(o4[3], (f32x4*)(o + 516));
    }
#undef FIN_LOAD
}

__global__ void __launch_bounds__(NTHREADS, 2) fwd_mega(Args args) {
    extern __shared__ __attribute__((aligned(16))) unsigned char lds_raw[];
    cg::grid_group grid = cg::this_grid();
    LAS unsigned char* lds = (LAS unsigned char*)lds_raw;
    const int wave = __builtin_amdgcn_readfirstlane((int)threadIdx.x >> 6);
#define lane ((int)__builtin_amdgcn_mbcnt_hi(~0u, __builtin_amdgcn_mbcnt_lo(~0u, 0u)))
    unsigned char* ws = args.ws;
    volatile LAS unsigned* xb_st = (volatile LAS unsigned*)(lds + LDS_BYTES - 64);
    if (threadIdx.x < 2) xb_st[threadIdx.x] = 0u;
    __syncthreads();
    const XcdBarrier xbar = xcd_barrier_post((unsigned*)(ws + WS_BAR), xb_st);
    float* ss = (float*)(ws + WS_SS);
    bf16* XB = (bf16*)(ws + WS_WD); bf16* HID = (bf16*)(ws + WS_P); bf16* YC = (bf16*)(ws + WS_YCAT);
    bf16* XS = (bf16*)args.out;
    const int lo = args.ph_lo, hi = args.ph_hi;
#define IN(k) (lo <= (k) && (k) < hi)
#define SEAM(k) do { if (IN(k) && IN((k) + 1)) xcd_barrier(xbar); } while (0)
    if (args.ph_hi > NPHASE) grid.sync();
    if (IN(0)) { p0_prologue(args, lds, wave, lane); __syncthreads(); } SEAM(0);
    if (IN(1)) {
        pg8::Gemm g{XB, (const bf16*)(ws + WS_W13_1), M, NUP, D}; pg8::StaticOrder S; S.init(M, NUP, gridDim.x, blockIdx.x);
        pg8::EpiScaled<1> E{HID, FF, ss, RMS_EPS};
        pg8::gemm_phase<pg8::EpiScaled<1>, pg8::StaticOrder, true, true>(lds, g, S, E, wave); } SEAM(1);
    if (IN(2)) {
        pg8::Gemm g{HID, (const bf16*)(ws + WS_W2_1), M, D, FF}; pg8::StaticOrder S; S.init(M, D, gridDim.x, blockIdx.x);
        pg8::EpiResid E{nullptr, XB, nullptr, XS, ss + M, 0.5f};
        pg8::gemm_phase<pg8::EpiResid, pg8::StaticOrder, true, true>(lds, g, S, E, wave); } SEAM(2);
    if (IN(3)) {
        pg8::Gemm g{XS, (const bf16*)(ws + WS_WIN), M, DIN, D}; pg8::StaticOrder S; S.init(M, DIN, gridDim.x, blockIdx.x);
        pg8::EpiScaled<0> E{HID, DIN, ss + M, RMS_EPS};
        pg8::gemm_phase<pg8::EpiScaled<0>, pg8::StaticOrder, true, true>(lds, g, S, E, wave); } SEAM(3);
    if (IN(4)) { mixer_prep(args, lds, wave, lane); } SEAM(4);
    if (IN(5)) { chunk_prep(args, lds, wave, lane); } SEAM(5);
    if (IN(6)) { scan_phase(args, lds, wave, lane); } SEAM(6);
    if (IN(7)) { post_phase(args, wave, lane); } SEAM(7);
    if (IN(8)) {
        pg8::Gemm g{YC, (const bf16*)(ws + WS_WOUT), M, D, D}; pg8::StaticOrder S; S.init(M, D, gridDim.x, blockIdx.x);
        pg8::EpiResid E{nullptr, XS, nullptr, XS, ss + 2 * M, 1.0f};
        pg8::gemm_phase<pg8::EpiResid, pg8::StaticOrder, true, true>(lds, g, S, E, wave); } SEAM(8);
    if (IN(9)) {
        pg8::Gemm g{XS, (const bf16*)(ws + WS_W13_2), M, NUP, D}; pg8::StaticOrder S; S.init(M, NUP, gridDim.x, blockIdx.x);
        pg8::EpiScaled<1> E{HID, FF, ss + 2 * M, RMS_EPS};
        pg8::gemm_phase<pg8::EpiScaled<1>, pg8::StaticOrder, true, true>(lds, g, S, E, wave); } SEAM(9);
    if (IN(10)) {
        pg8::Gemm g{HID, (const bf16*)(ws + WS_W2_2), M, D, FF}; pg8::StaticOrder S; S.init(M, D, gridDim.x, blockIdx.x);
        pg8::EpiResid E{nullptr, XS, nullptr, XB, ss + 3 * M, 0.5f};
        pg8::gemm_phase<pg8::EpiResid, pg8::StaticOrder, true, true>(lds, g, S, E, wave); } SEAM(10);
    if (IN(11)) { final_phase(args, wave, lane); }
#undef IN
#undef SEAM
#undef lane
}

extern "C" void kernel_launch(void* const* d_in, const int* in_sizes, int n_in, void* d_out, int out_size, void* d_ws, size_t ws_size, hipStream_t stream) {
    static int grid = 0;
    if (grid == 0) {
        if (n_in != 28 || in_sizes[0] != M * D || out_size != M * D || ws_size < WS_END) { fprintf(stderr, "kernel_launch: unexpected shapes: n_in %d in0 %d out %d ws %zu (need %zu)\n", n_in, n_in > 0 ? in_sizes[0] : -1, out_size, ws_size, (size_t)WS_END); grid = -1; return; }
        int dev = 0, cus = 0, per_cu = 0;
        hipGetDevice(&dev); hipDeviceGetAttribute(&cus, hipDeviceAttributeMultiprocessorCount, dev);
        if (hipFuncSetAttribute((const void*)fwd_mega, hipFuncAttributeMaxDynamicSharedMemorySize, LDS_BYTES) != hipSuccess) { fprintf(stderr, "kernel_launch: hipFuncSetAttribute failed\n"); grid = -1; return; }
        if (hipOccupancyMaxActiveBlocksPerMultiprocessor(&per_cu, (const void*)fwd_mega, NTHREADS, LDS_BYTES) != hipSuccess || per_cu < 1) { fprintf(stderr, "kernel_launch: occupancy query says %d blocks per CU\n", per_cu); per_cu = 1; }
        (void)hipGetLastError();
        grid = cus * per_cu; if (grid > 256) grid = 256;
    }
    if (grid < 0) return;
    if (hipMemsetAsync((char*)d_ws + WS_BAR, 0, 16384, stream) != hipSuccess) { fprintf(stderr, "kernel_launch: hipMemsetAsync of the barrier words failed\n"); return; }
    Args a{};
    for (int i = 0; i < 28; ++i) a.in[i] = (const float*)d_in[i];
    a.out = (float*)d_out; a.ws = (unsigned char*)d_ws;
#if MK_SPLIT
    for (int p = 0; p < NPHASE; ++p) { a.ph_lo = p; a.ph_hi = p + 1; void* kargs[] = {&a};
        hipError_t e = hipLaunchCooperativeKernel((const void*)fwd_mega, dim3(grid), dim3(NTHREADS), kargs, LDS_BYTES, stream);
        if (e != hipSuccess) { fprintf(stderr, "kernel_launch: launch of phase %d failed: %s\n", p, hipGetErrorString(e)); break; } }
#else
    a.ph_lo = 0; a.ph_hi = NPHASE; void* kargs[] = {&a};
    hipError_t e = hipLaunchCooperativeKernel((const void*)fwd_mega, dim3(grid), dim3(NTHREADS), kargs, LDS_BYTES, stream);
    if (e != hipSuccess) fprintf(stderr, "kernel_launch: cooperative launch failed: %s (grid %d)\n", hipGetErrorString(e), grid);
#endif
}
```
